# Optimizing an MI355X kernel written in HIP

```python
import functools
import jax, jax.numpy as jnp
from jax import lax
import numpy as np

D_MODEL = 2048
BATCH = 4
SEQ = 4096
DEPTH = 1
DEC_BATCH = 128
DEC_SEQ = 4
PAST_LEN = 16384
PAGE_SIZE = 128

D_RNN = D_MODEL // 2
RNN_BLOCKS = 8
RNN_BLOCK = D_RNN // RNN_BLOCKS
CONV_W = 4
LRU_C = 8.0
HEAD_DIM = 64
N_Q_HEADS = D_MODEL // 2 // HEAD_DIM
N_KV_HEADS = 4
GROUP = N_Q_HEADS // N_KV_HEADS
WINDOW = 128
ROT_DIM = HEAD_DIM // 4
ROPE_THETA = 500000.0
N_KEYS = 128
N_EXPERTS = N_KEYS * N_KEYS
PEER_HEADS = 8
PEER_TOPK = 16
D_KEY = 256
PEER_CHUNK = 128
D_PLE = 256
EPS = 1e-6
NEG_INF = -1e30
IN_SIZES = [D_RNN, D_RNN, N_Q_HEADS * HEAD_DIM, N_KV_HEADS * HEAD_DIM, N_KV_HEADS * HEAD_DIM, D_MODEL, D_MODEL]
D_IN = sum(IN_SIZES)

kernel_name = "hawk_swa_sink_peer_hybrid_step"


def rmsnorm(x, g):
    xf = x.astype(jnp.float32)
    y = xf * lax.rsqrt(jnp.mean(xf * xf, axis=-1, keepdims=True) + EPS) * g.astype(jnp.float32)
    return y.astype(x.dtype)


def rope_partial(x, pos):
    half = ROT_DIM // 2
    inv = ROPE_THETA ** (-jnp.arange(0, ROT_DIM, 2, dtype=jnp.float32) / ROT_DIM)
    ang = pos.astype(jnp.float32)[:, None] * inv[None, :]
    cos = jnp.cos(ang)[:, None, :]
    sin = jnp.sin(ang)[:, None, :]
    xf = x.astype(jnp.float32)
    x1, x2 = xf[..., :half], xf[..., half:ROT_DIM]
    y = jnp.concatenate([x1 * cos - x2 * sin, x2 * cos + x1 * sin, xf[..., ROT_DIM:]], axis=-1)
    return y.astype(x.dtype)


def causal_conv(x, buf, w, b):
    T = x.shape[1]
    xp = jnp.concatenate([buf.astype(x.dtype), x], axis=1)
    y = b + sum(w[k] * xp[:, k:k + T] for k in range(CONV_W))
    return y, xp[:, xp.shape[1] - (CONV_W - 1):]


def linear_recurrence(a, b, h0):
    b = b.at[:, 0].add(a[:, 0] * h0)

    def combine(c1, c2):
        a1, b1 = c1
        a2, b2 = c2
        return a1 * a2, a2 * b1 + b2

    _, h = lax.associative_scan(combine, (a, b), axis=1)
    return h


def rglru(x, h0, pos, w_r, b_r, w_i, b_i, lam):
    B, T, _ = x.shape
    xb = x.reshape(B, T, RNN_BLOCKS, RNN_BLOCK)
    r = jax.nn.sigmoid((jnp.einsum('btnc,ncd->btnd', xb, w_r).reshape(B, T, D_RNN) + b_r).astype(jnp.float32))
    i = jax.nn.sigmoid((jnp.einsum('btnc,ncd->btnd', xb, w_i).reshape(B, T, D_RNN) + b_i).astype(jnp.float32))
    log_a = -LRU_C * r * jax.nn.softplus(-lam.astype(jnp.float32))
    a = jnp.exp(log_a)
    mult = jnp.where(pos[None, :, None] == 0, 1.0, jnp.sqrt(-jnp.expm1(2.0 * log_a)))
    h = linear_recurrence(a, mult * i * x.astype(jnp.float32), h0.astype(jnp.float32))
    return h.astype(x.dtype), h[:, -1]


def sink_attention(q, k, v, mask, sinks):
    s = jnp.einsum('bnqkgd,bnskd->bnkgqs', q.astype(jnp.float32), k.astype(jnp.float32)) * (HEAD_DIM ** -0.5)
    s = jnp.where(mask[None, :, None, None], s, NEG_INF)
    sk = sinks.astype(jnp.float32).reshape(N_KV_HEADS, GROUP)[None, None, :, :, None, None]
    m = jnp.maximum(jnp.max(s, axis=-1, keepdims=True), sk)
    p = jnp.exp(s - m)
    denom = jnp.sum(p, axis=-1, keepdims=True) + jnp.exp(sk - m)
    return jnp.einsum('bnkgqs,bnskd->bnqkgd', p / denom, v.astype(jnp.float32))


def swa_prompt(q, k, v, sinks):
    B, S = q.shape[:2]
    nb = S // WINDOW
    qb = q.reshape(B, nb, WINDOW, N_KV_HEADS, GROUP, HEAD_DIM)
    kb = k.reshape(B, nb, WINDOW, N_KV_HEADS, HEAD_DIM)
    vb = v.reshape(B, nb, WINDOW, N_KV_HEADS, HEAD_DIM)
    kk = jnp.concatenate([jnp.concatenate([jnp.zeros_like(kb[:, :1]), kb[:, :-1]], axis=1), kb], axis=2)
    vv = jnp.concatenate([jnp.concatenate([jnp.zeros_like(vb[:, :1]), vb[:, :-1]], axis=1), vb], axis=2)
    i = jnp.arange(WINDOW)[:, None]
    j = jnp.arange(2 * WINDOW)[None, :]
    d = WINDOW + i - j
    valid = (d >= 0) & (d < WINDOW)
    mask = jnp.where(jnp.arange(nb)[:, None, None] == 0, valid & (j >= WINDOW), valid)
    o = sink_attention(qb, kk, vv, mask, sinks).reshape(B, S, N_Q_HEADS * HEAD_DIM)
    keep = min(WINDOW, S)
    return o, k[:, S - keep:], v[:, S - keep:]


def swa_sample(q, k, v, sinks, cache_k, cache_v, past_len):
    B, T = q.shape[:2]
    w_buf = cache_k.shape[1]
    kk = jnp.concatenate([cache_k.astype(k.dtype), k], axis=1)
    vv = jnp.concatenate([cache_v.astype(v.dtype), v], axis=1)
    qpos = past_len + jnp.arange(T)
    kpos = past_len - w_buf + jnp.arange(w_buf + T)
    d = qpos[:, None] - kpos[None, :]
    mask = (d >= 0) & (d < WINDOW)
    o = sink_attention(q.reshape(B, 1, T, N_KV_HEADS, GROUP, HEAD_DIM), kk[:, None], vv[:, None], mask[None], sinks)
    o = o.reshape(B, T, N_Q_HEADS * HEAD_DIM)
    return o, kk[:, kk.shape[1] - w_buf:], vv[:, vv.shape[1] - w_buf:]


def peer(x, w_q, sub_keys, u, v):
    B, T, D = x.shape
    n = B * T
    xt = x.reshape(n, D)
    q = (xt @ w_q).reshape(n, PEER_HEADS, 2, D_KEY // 2)
    s = jnp.einsum('nhpd,hpkd->nhpk', q.astype(jnp.float32), sub_keys.astype(jnp.float32))
    s1, i1 = lax.top_k(s[:, :, 0], PEER_TOPK)
    s2, i2 = lax.top_k(s[:, :, 1], PEER_TOPK)
    cand = (s1[..., :, None] + s2[..., None, :]).reshape(n, PEER_HEADS, PEER_TOPK * PEER_TOPK)
    cidx = (i1[..., :, None] * N_KEYS + i2[..., None, :]).reshape(n, PEER_HEADS, PEER_TOPK * PEER_TOPK)
    top_s, sel = lax.top_k(cand, PEER_TOPK)
    idx = jnp.take_along_axis(cidx, sel, axis=-1)
    g = jax.nn.softmax(top_s, axis=-1)
    n_pad = -(-n // PEER_CHUNK) * PEER_CHUNK
    pad = n_pad - n
    nc = n_pad // PEER_CHUNK
    xc = jnp.pad(xt, ((0, pad), (0, 0))).reshape(nc, PEER_CHUNK, D)
    ic = jnp.pad(idx, ((0, pad), (0, 0), (0, 0))).reshape(nc, PEER_CHUNK, PEER_HEADS, PEER_TOPK)
    gc = jnp.pad(g, ((0, pad), (0, 0), (0, 0))).reshape(nc, PEER_CHUNK, PEER_HEADS, PEER_TOPK)

    def chunk(args):
        xb, ib, gb = args
        hb = jax.nn.gelu(jnp.einsum('chkd,cd->chk', u[ib], xb).astype(jnp.float32))
        return jnp.einsum('chk,chkd->cd', (hb * gb).astype(v.dtype), v[ib])

    out = lax.map(chunk, (xc, ic, gc))
    return out.reshape(n_pad, D)[:n].reshape(B, T, D).astype(x.dtype)


def decoder_layer(x, ple, pos, conv_buf, h0, attn_fn, norm_mix, w_in, conv_w, conv_b, w_rgate, b_rgate,
                  w_igate, b_igate, lru_lambda, w_proj_rnn, q_norm, k_norm, attn_sinks, w_proj_attn, w_out,
                  norm_ffn, w_peer_q, peer_sub_keys, peer_u, peer_v, w_ple, norm_ple, w_ple_gate):
    B, T, _ = x.shape
    n1 = rmsnorm(x, norm_mix)
    z = n1 @ w_in
    offs = np.cumsum(IN_SIZES)[:-1].tolist()
    xr, gr, q, k, v, ga, gb = jnp.split(z, offs, axis=-1)
    xr, conv_new = causal_conv(xr, conv_buf, conv_w, conv_b)
    hr, h_last = rglru(xr, h0, pos, w_rgate, b_rgate, w_igate, b_igate, lru_lambda)
    branch_a = (hr * jax.nn.gelu(gr)) @ w_proj_rnn
    q = rope_partial(rmsnorm(q.reshape(B, T, N_Q_HEADS, HEAD_DIM), q_norm), pos)
    k = rope_partial(rmsnorm(k.reshape(B, T, N_KV_HEADS, HEAD_DIM), k_norm), pos)
    v = v.reshape(B, T, N_KV_HEADS, HEAD_DIM)
    o, k_buf, v_buf = attn_fn(q, k, v, attn_sinks)
    branch_b = o.astype(x.dtype) @ w_proj_attn
    merged = jax.nn.sigmoid(ga) * branch_a + jax.nn.sigmoid(gb) * branch_b
    x = x + merged @ w_out
    x = x + peer(rmsnorm(x, norm_ffn), w_peer_q, peer_sub_keys, peer_u, peer_v)
    x = x + (ple @ w_ple) * jax.nn.sigmoid(rmsnorm(x, norm_ple) @ w_ple_gate)
    return x, conv_new, h_last, k_buf, v_buf


def setup_inputs(seed: int = 0) -> dict:
    key = jax.random.key(seed)
    ks = jax.random.split(key, 40)
    f32 = jnp.float32
    nrm = lambda k, shape, scale: jax.random.normal(k, shape, f32) * scale
    w_buf = min(WINDOW, PAST_LEN)
    a0 = jax.random.uniform(ks[20], (DEPTH, D_RNN), f32, 0.9, 0.999)
    return {
        "x_prompt": nrm(ks[0], (BATCH, SEQ, D_MODEL), 1.0),
        "x_sample": nrm(ks[1], (DEC_BATCH, DEC_SEQ, D_MODEL), 1.0),
        "p_prompt": nrm(ks[2], (DEPTH, BATCH, SEQ, D_PLE), 1.0),
        "p_sample": nrm(ks[3], (DEPTH, DEC_BATCH, DEC_SEQ, D_PLE), 1.0),
        "state_conv": nrm(ks[4], (DEPTH, DEC_BATCH, CONV_W - 1, D_RNN), 1.0),
        "state_rglru": nrm(ks[5], (DEPTH, DEC_BATCH, D_RNN), 0.5),
        "cache_k": nrm(ks[6], (DEPTH, DEC_BATCH, w_buf, N_KV_HEADS, HEAD_DIM), 1.0),
        "cache_v": nrm(ks[7], (DEPTH, DEC_BATCH, w_buf, N_KV_HEADS, HEAD_DIM), 1.0),
        "norm_mix": 1.0 + nrm(ks[8], (DEPTH, D_MODEL), 0.01),
        "w_in": nrm(ks[9], (DEPTH, D_MODEL, D_IN), D_MODEL ** -0.5),
        "conv_w": nrm(ks[10], (DEPTH, CONV_W, D_RNN), CONV_W ** -0.5),
        "conv_b": nrm(ks[11], (DEPTH, D_RNN), 0.01),
        "w_rgate": nrm(ks[12], (DEPTH, RNN_BLOCKS, RNN_BLOCK, RNN_BLOCK), RNN_BLOCK ** -0.5),
        "b_rgate": nrm(ks[13], (DEPTH, D_RNN), 0.01),
        "w_igate": nrm(ks[14], (DEPTH, RNN_BLOCKS, RNN_BLOCK, RNN_BLOCK), RNN_BLOCK ** -0.5),
        "b_igate": nrm(ks[15], (DEPTH, D_RNN), 0.01),
        "lru_lambda": jnp.log(a0) - jnp.log1p(-a0),
        "w_proj_rnn": nrm(ks[16], (DEPTH, D_RNN, D_MODEL), D_RNN ** -0.5),
        "q_norm": 1.0 + nrm(ks[17], (DEPTH, HEAD_DIM), 0.01),
        "k_norm": 1.0 + nrm(ks[18], (DEPTH, HEAD_DIM), 0.01),
        "attn_sinks": nrm(ks[19], (DEPTH, N_Q_HEADS), 0.5),
        "w_proj_attn": nrm(ks[21], (DEPTH, N_Q_HEADS * HEAD_DIM, D_MODEL), (N_Q_HEADS * HEAD_DIM) ** -0.5),
        "w_out": nrm(ks[22], (DEPTH, D_MODEL, D_MODEL), D_MODEL ** -0.5),
        "norm_ffn": 1.0 + nrm(ks[23], (DEPTH, D_MODEL), 0.01),
        "w_peer_q": nrm(ks[24], (DEPTH, D_MODEL, PEER_HEADS * D_KEY), D_MODEL ** -0.5),
        "peer_sub_keys": nrm(ks[25], (DEPTH, PEER_HEADS, 2, N_KEYS, D_KEY // 2), (D_KEY // 2) ** -0.5),
        "peer_u": nrm(ks[26], (DEPTH, N_EXPERTS, D_MODEL), D_MODEL ** -0.5),
        "peer_v": nrm(ks[27], (DEPTH, N_EXPERTS, D_MODEL), (PEER_HEADS * PEER_TOPK) ** -0.5),
        "w_ple": nrm(ks[28], (DEPTH, D_PLE, D_MODEL), D_PLE ** -0.5),
        "norm_ple": 1.0 + nrm(ks[29], (DEPTH, D_MODEL), 0.01),
        "w_ple_gate": nrm(ks[30], (DEPTH, D_MODEL, D_MODEL), D_MODEL ** -0.5),
    }


def reference(x_prompt, x_sample, p_prompt, p_sample, state_conv, state_rglru, cache_k, cache_v,
              norm_mix, w_in, conv_w, conv_b, w_rgate, b_rgate, w_igate, b_igate, lru_lambda, w_proj_rnn,
              q_norm, k_norm, attn_sinks, w_proj_attn, w_out, norm_ffn, w_peer_q, peer_sub_keys, peer_u,
              peer_v, w_ple, norm_ple, w_ple_gate):
    B, S, _ = x_prompt.shape
    DB, DS, _ = x_sample.shape
    pos_prompt = jnp.arange(S, dtype=jnp.int32)
    pos_sample = PAST_LEN + jnp.arange(DS, dtype=jnp.int32)
    yp, ys = x_prompt, x_sample
    pc, ph, pk, pv, sc, sh, sk, sv = [], [], [], [], [], [], [], []
    for l in range(DEPTH):
        w = (norm_mix[l], w_in[l], conv_w[l], conv_b[l], w_rgate[l], b_rgate[l], w_igate[l], b_igate[l],
             lru_lambda[l], w_proj_rnn[l], q_norm[l], k_norm[l], attn_sinks[l], w_proj_attn[l], w_out[l],
             norm_ffn[l], w_peer_q[l], peer_sub_keys[l], peer_u[l], peer_v[l], w_ple[l], norm_ple[l],
             w_ple_gate[l])
        yp, c_new, h_new, k_new, v_new = decoder_layer(
            yp, p_prompt[l], pos_prompt,
            jnp.zeros((B, CONV_W - 1, D_RNN), x_prompt.dtype), jnp.zeros((B, D_RNN), jnp.float32),
            swa_prompt, *w)
        pc.append(c_new); ph.append(h_new); pk.append(k_new); pv.append(v_new)
        attn_fn = functools.partial(swa_sample, cache_k=cache_k[l], cache_v=cache_v[l], past_len=PAST_LEN)
        ys, c_new, h_new, k_new, v_new = decoder_layer(
            ys, p_sample[l], pos_sample, state_conv[l], state_rglru[l], attn_fn, *w)
        sc.append(c_new); sh.append(h_new); sk.append(k_new); sv.append(v_new)
    prompt_conv, prompt_rglru = jnp.stack(pc), jnp.stack(ph)
    prompt_k, prompt_v = jnp.stack(pk), jnp.stack(pv)
    sample_conv, sample_rglru = jnp.stack(sc), jnp.stack(sh)
    sample_k, sample_v = jnp.stack(sk), jnp.stack(sv)
    return (yp, ys, prompt_conv, prompt_rglru, prompt_k, prompt_v, sample_conv, sample_rglru, sample_k, sample_v)
```

```cpp
#include <hip/hip_runtime.h>
#include <hip/hip_cooperative_groups.h>
#include <stdint.h>
#include <cstdio>
namespace cg = cooperative_groups;

#ifndef MEGA
#define MEGA 1
#endif

typedef unsigned short bf16_t;
using bf16x8 = __attribute__((ext_vector_type(8))) short;
using f32x16 = __attribute__((ext_vector_type(16))) float;
using u32x8 = __attribute__((ext_vector_type(8))) unsigned;
using u32x2 = __attribute__((ext_vector_type(2))) unsigned;

#define NTOK 16896
#define NPROMPT 16384
#define EPSF 1e-6f

#define OFF_R1   ((size_t)0)
#define OFF_ZR   (OFF_R1 + (size_t)69206016)
#define OFF_ZG   (OFF_ZR + (size_t)121110528)
#define OFF_W    (OFF_ZG + (size_t)138412032)
#define OFF_U    (OFF_W + (size_t)67108864)
#define OFF_V    (OFF_U + (size_t)33554432)
#define OFF_SUM  (OFF_V + (size_t)33554432)
#define OFF_ROPE (OFF_SUM + (size_t)4194304)
#define OFF_PLB  (OFF_ROPE + (size_t)262400)
#define OFF_BAR  (OFF_PLB + (size_t)8650752)
#define WS_NEED  (OFF_BAR + (size_t)16384)

#define W_IN   ((size_t)0)
#define W_RNN  (W_IN + (size_t)7680 * 2048)
#define W_ATT  (W_RNN + (size_t)2048 * 1024)
#define W_OUT  (W_ATT + (size_t)2048 * 1024)
#define W_PQ   (W_OUT + (size_t)2048 * 2048)
#define W_PLE  (W_PQ + (size_t)2048 * 2048)
#define W_GATE (W_PLE + (size_t)2048 * 256)
#define W_RG   (W_GATE + (size_t)2048 * 2048)
#define W_IG   (W_RG + (size_t)8 * 128 * 128)
#define W_SK   (W_IG + (size_t)8 * 128 * 128)

#define O_Y      ((size_t)0)
#define O_PCONV  ((size_t)34603008)
#define O_PRG    ((size_t)34615296)
#define O_PK     ((size_t)34619392)
#define O_PV     ((size_t)34750464)
#define O_SCONV  ((size_t)34881536)
#define O_SRG    ((size_t)35274752)
#define O_SK     ((size_t)35405824)
#define O_SV     ((size_t)39600128)

struct Params {
  const float *x_prompt, *x_sample, *p_prompt, *p_sample, *state_conv, *state_rglru, *cache_k, *cache_v;
  const float *norm_mix, *w_in, *conv_w, *conv_b, *w_rgate, *b_rgate, *w_igate, *b_igate, *lru_lambda, *w_proj_rnn;
  const float *q_norm, *k_norm, *attn_sinks, *w_proj_attn, *w_out, *norm_ffn, *w_peer_q, *sub_keys, *peer_u, *peer_v;
  const float *w_ple, *norm_ple, *w_ple_gate;
  float* out;
  char* ws;
};

typedef const __attribute__((address_space(4))) Params CParams;
__device__ __forceinline__ CParams* get_params() {
  CParams* kp = (CParams*)__builtin_amdgcn_kernarg_segment_ptr();
  asm volatile("" : "+s"(kp));
  return kp;
}
__device__ __forceinline__ bf16_t f2bf(float f) {
  unsigned u = __float_as_uint(f);
  u += 0x7fffu + ((u >> 16) & 1u);
  return (bf16_t)(u >> 16);
}
__device__ __forceinline__ float bf2f(bf16_t b) { return __uint_as_float(((unsigned)b) << 16); }
__device__ __forceinline__ unsigned pack2(float a, float b) { return (unsigned)f2bf(a) | ((unsigned)f2bf(b) << 16); }
__device__ __forceinline__ float lo2f(unsigned d) { return __uint_as_float(d << 16); }
__device__ __forceinline__ float hi2f(unsigned d) { return __uint_as_float(d & 0xffff0000u); }
__device__ __forceinline__ float sigmoidf_(float x) { return __builtin_amdgcn_rcpf(1.f + __expf(-x)); }
__device__ __forceinline__ float gelu_tanh(float x) {
  float y = 0.7978845608028654f * (x + 0.044715f * x * x * x);
  float th = 1.f - 2.f * __builtin_amdgcn_rcpf(1.f + __expf(2.f * y));
  return 0.5f * x * (1.f + th);
}
__device__ __forceinline__ float wave_sum(float v) {
#pragma unroll
  for (int o = 32; o; o >>= 1) v += __shfl_xor(v, o);
  return v;
}
__device__ __forceinline__ float wave_max(float v) {
#pragma unroll
  for (int o = 32; o; o >>= 1) v = fmaxf(v, __shfl_xor(v, o));
  return v;
}
__device__ __forceinline__ void unpack8(const uint4& u, float* f) {
  f[0] = lo2f(u.x); f[1] = hi2f(u.x); f[2] = lo2f(u.y); f[3] = hi2f(u.y);
  f[4] = lo2f(u.z); f[5] = hi2f(u.z); f[6] = lo2f(u.w); f[7] = hi2f(u.w);
}
__device__ __forceinline__ uint4 pack8(const float* f) {
  uint4 u; u.x = pack2(f[0], f[1]); u.y = pack2(f[2], f[3]); u.z = pack2(f[4], f[5]); u.w = pack2(f[6], f[7]);
  return u;
}
__device__ __forceinline__ const float* x_row(CParams& p, int tok) {
  return tok < NPROMPT ? p.x_prompt + (size_t)tok * 2048 : p.x_sample + (size_t)(tok - NPROMPT) * 2048;
}
__device__ __forceinline__ const float* ple_row(CParams& p, int tok) {
  return tok < NPROMPT ? p.p_prompt + (size_t)tok * 256 : p.p_sample + (size_t)(tok - NPROMPT) * 256;
}

__device__ __forceinline__ bool tile_at(int q, int x, int SM, int SN, int NSM, int NSN, int& mt, int& nt) {
  int ST = SM * SN;
  int sup = (q / ST) * 8 + x;
  if (sup >= NSM * NSN) return false;
  int wi = q % ST;
  mt = (sup / NSN) * SM + wi / SN;
  nt = (sup % NSN) * SN + wi % SN;
  return true;
}

using f32x4 = __attribute__((ext_vector_type(4))) float;
__device__ __forceinline__ void stage_rc(int b, int& R, int& C) {
  int st = b >> 10, sb = b & 1023, swz = sb ^ (((sb >> 9) & 1) << 5);
  R = (st >> 1) * 16 + (swz >> 6);
  C = (st & 1) * 32 + ((swz & 63) >> 1);
}
__device__ __forceinline__ void gemm_loop(f32x4 (&acc)[4][4], const bf16_t* __restrict__ A, int lda,
                                          const bf16_t* __restrict__ B, int ldb, int K, char* smem) {
  const int t = threadIdx.x, lane = t & 63, w = t >> 6, wm = w >> 1, wn = w & 1;
  const int fr = lane & 15, fq = lane >> 4;
  unsigned aoff[4], boff[4];
#pragma unroll
  for (int i = 0; i < 4; i++) {
    int R, C;
    stage_rc(t * 16 + i * 4096, R, C);
    aoff[i] = R * lda + C;
    boff[i] = R * ldb + C;
  }
#define GL_STAGE(s, ko)                                                                                             \
  _Pragma("unroll") for (int i_ = 0; i_ < 4; i_++) {                                                                \
    __builtin_amdgcn_global_load_lds((const unsigned*)(A + aoff[i_] + (ko)),                                        \
                                     (unsigned*)(smem + (s) * 32768 + t * 16 + i_ * 4096), 16, 0, 0);               \
    __builtin_amdgcn_global_load_lds((const unsigned*)(B + boff[i_] + (ko)),                                        \
                                     (unsigned*)(smem + (s) * 32768 + 16384 + t * 16 + i_ * 4096), 16, 0, 0);       \
  }
  const int lane_off = ((fr * 64 + fq * 16) ^ ((fr >> 3) << 5));
  const int a_base = wm * 8192 + lane_off, b_base = 16384 + wn * 8192 + lane_off;
  __syncthreads();
  GL_STAGE(0, 0)
  const int nt = K >> 6;
  for (int kt = 0; kt < nt; kt++) {
    const int cur = kt & 1;
    __syncthreads();
    if (kt + 1 < nt) { GL_STAGE(cur ^ 1, (kt + 1) * 64) }
    const char* sb = smem + cur * 32768;
#pragma unroll
    for (int k2 = 0; k2 < 2; k2++) {
      bf16x8 af[4], bfr[4];
#pragma unroll
      for (int m = 0; m < 4; m++) af[m] = *(const bf16x8*)(sb + a_base + m * 2048 + k2 * 1024);
#pragma unroll
      for (int n = 0; n < 4; n++) bfr[n] = *(const bf16x8*)(sb + b_base + n * 2048 + k2 * 1024);
#pragma unroll
      for (int n = 0; n < 4; n++)
#pragma unroll
        for (int m = 0; m < 4; m++) acc[n][m] = __builtin_amdgcn_mfma_f32_16x16x32_bf16(bfr[n], af[m], acc[n][m], 0, 0, 0);
    }
  }
}
__device__ __forceinline__ void zero_acc4(f32x4 (&acc)[4][4]) {
#pragma unroll
  for (int i = 0; i < 4; i++)
#pragma unroll
    for (int j = 0; j < 4; j++) acc[i][j] = (f32x4){0.f, 0.f, 0.f, 0.f};
}
#define LROW2 (wm * 64 + (lane & 15))
#define LCOL2 (wn * 64 + (lane >> 4) * 4)

#define G3_STAGE_BYTES 40960
#define G3_B_OFF 24576
__device__ __forceinline__ void gemm_loop3(f32x4 (&acc)[4][6], const bf16_t* __restrict__ A, int lda,
                                           const bf16_t* __restrict__ B, int ldb, int K, char* smem) {
  const int t = threadIdx.x, lane = t & 63, w = t >> 6, wm = w >> 1, wn = w & 1;
  const int fr = lane & 15, fq = lane >> 4;
  unsigned aoff[6], boff[4];
#pragma unroll
  for (int i = 0; i < 6; i++) {
    int R, C;
    stage_rc(t * 16 + i * 4096, R, C);
    aoff[i] = R * lda + C;
    if (i < 4) { const int rho = R & 31, Rp = (R & ~31) + 8 * ((rho & 15) >> 2) + 4 * (rho >> 4) + (rho & 3); boff[i] = Rp * ldb + C; }
  }
#define G3_ISSUE(s, ko)                                                                                        \
  {                                                                                                            \
    char* sb_ = smem + (s) * G3_STAGE_BYTES + t * 16;                                                          \
    _Pragma("unroll") for (int i_ = 0; i_ < 6; i_++)                                                           \
        __builtin_amdgcn_global_load_lds((const unsigned*)(A + (unsigned)(aoff[i_] + (ko))), (unsigned*)(sb_ + i_ * 4096), 16, 0, 0); \
    _Pragma("unroll") for (int i_ = 0; i_ < 4; i_++)                                                           \
        __builtin_amdgcn_global_load_lds((const unsigned*)(B + (unsigned)(boff[i_] + (ko))), (unsigned*)(sb_ + G3_B_OFF + i_ * 4096), 16, 0, 0); \
  }
  const int lane_off = ((fr * 64 + fq * 16) ^ ((fr >> 3) << 5));
  const int a_base = wm * 12288 + lane_off, b_base = G3_B_OFF + wn * 8192 + lane_off;
  __syncthreads();
  const int nt = K >> 6;
  G3_ISSUE(0, 0)
  for (int kt = 0; kt < nt; kt++) {
    const int cur = kt & 1;
    __syncthreads();
    if (kt + 1 < nt) G3_ISSUE(cur ^ 1, (kt + 1) * 64)
    const char* sb = smem + cur * G3_STAGE_BYTES;
#pragma unroll
    for (int k2 = 0; k2 < 2; k2++) {
      bf16x8 af[6], bfr[4];
#pragma unroll
      for (int m = 0; m < 6; m++) af[m] = *(const bf16x8*)(sb + a_base + m * 2048 + k2 * 1024);
#pragma unroll
      for (int n = 0; n < 4; n++) bfr[n] = *(const bf16x8*)(sb + b_base + n * 2048 + k2 * 1024);
#pragma unroll
      for (int n = 0; n < 4; n++)
#pragma unroll
        for (int m = 0; m < 6; m++) acc[n][m] = __builtin_amdgcn_mfma_f32_16x16x32_bf16(bfr[n], af[m], acc[n][m], 0, 0, 0);
      __builtin_amdgcn_sched_barrier(0);
    }
  }
}
__device__ __forceinline__ void zero_acc6(f32x4 (&acc)[4][6]) {
#pragma unroll
  for (int i = 0; i < 4; i++)
#pragma unroll
    for (int j = 0; j < 6; j++) acc[i][j] = (f32x4){0.f, 0.f, 0.f, 0.f};
}
#define LROW3 (wm * 96 + (lane & 15))
#define LCOL8 (wn * 64 + (lane >> 4) * 8)

__device__ __forceinline__ void lds_gemm128(f32x16 (&acc)[2][2], const bf16_t (*A2)[136], const bf16_t (*B2)[136]) {
  const int t = threadIdx.x, lane = t & 63, w = t >> 6, wm = w >> 1, wn = w & 1;
  const int fr = lane & 31, fk = (lane >> 5) * 8;
#pragma unroll
  for (int kk = 0; kk < 8; kk++) {
    bf16x8 a0 = *(const bf16x8*)&A2[wm * 64 + fr][kk * 16 + fk];
    bf16x8 a1 = *(const bf16x8*)&A2[wm * 64 + 32 + fr][kk * 16 + fk];
    bf16x8 b0 = *(const bf16x8*)&B2[wn * 64 + fr][kk * 16 + fk];
    bf16x8 b1 = *(const bf16x8*)&B2[wn * 64 + 32 + fr][kk * 16 + fk];
    acc[0][0] = __builtin_amdgcn_mfma_f32_32x32x16_bf16(a0, b0, acc[0][0], 0, 0, 0);
    acc[0][1] = __builtin_amdgcn_mfma_f32_32x32x16_bf16(a0, b1, acc[0][1], 0, 0, 0);
    acc[1][0] = __builtin_amdgcn_mfma_f32_32x32x16_bf16(a1, b0, acc[1][0], 0, 0, 0);
    acc[1][1] = __builtin_amdgcn_mfma_f32_32x32x16_bf16(a1, b1, acc[1][1], 0, 0, 0);
  }
}
__device__ __forceinline__ void load_b2(bf16_t (*B2)[136], const bf16_t* __restrict__ src) {
  const int t = threadIdx.x;
#pragma unroll
  for (int i = 0; i < 8; i++) {
    int c = t + 256 * i, row = c >> 4, col = (c & 15) * 8;
    *(uint4*)&B2[row][col] = *(const uint4*)(src + row * 128 + col);
  }
}
__device__ __forceinline__ void zero_acc(f32x16 (&acc)[2][2]) {
#pragma unroll
  for (int i = 0; i < 2; i++)
#pragma unroll
    for (int j = 0; j < 2; j++)
#pragma unroll
      for (int r = 0; r < 16; r++) acc[i][j][r] = 0.f;
}
#define ACC_ROW(i, r) (wm * 64 + (i) * 32 + ((r) & 3) + 8 * ((r) >> 2) + 4 * (lane >> 5))
#define ACC_COL(j) (wn * 64 + (j) * 32 + (lane & 31))
#define EPI_VARS const int lane = threadIdx.x & 63, wm = threadIdx.x >> 7, wn = (threadIdx.x >> 6) & 1;
#define ROWC(i, r) ((i) * 32 + ((r) & 3) + 8 * ((r) >> 2))
#define LROW (wm * 64 + 4 * (lane >> 5))
#define LCOL (wn * 64 + (lane & 31))
__device__ __forceinline__ unsigned opaque_u(unsigned v) { asm volatile("" : "+v"(v)); return v; }

typedef float nt_f4 __attribute__((ext_vector_type(4)));
__device__ __forceinline__ float4 ld_nt4(const float* p) { nt_f4 v = __builtin_nontemporal_load((const nt_f4*)p); return make_float4(v.x, v.y, v.z, v.w); }
__device__ void transpose_tile(const float* __restrict__ src, int ld_src, bf16_t* __restrict__ dst, int ld_dst,
                               int k0, int n0, const float* __restrict__ kscale, char* smem) {
  float (*tile)[65] = (float (*)[65])smem;
  const int t = threadIdx.x;
  __syncthreads();
  const int n4 = (t & 15) * 4, kr = t >> 4;
#pragma unroll
  for (int i = 0; i < 4; i++) {
    int k = kr + 16 * i;
    float4 v = ld_nt4(src + (size_t)(k0 + k) * ld_src + n0 + n4);
    float s = kscale ? kscale[k0 + k] : 1.f;
    tile[k][n4 + 0] = v.x * s; tile[k][n4 + 1] = v.y * s; tile[k][n4 + 2] = v.z * s; tile[k][n4 + 3] = v.w * s;
  }
  __syncthreads();
  const int n = t >> 2, ks = (t & 3) * 16;
  float f[16];
#pragma unroll
  for (int j = 0; j < 16; j++) f[j] = tile[ks + j][n];
  uint4* d = (uint4*)(dst + (size_t)(n0 + n) * ld_dst + k0 + ks);
  d[0] = pack8(f); d[1] = pack8(f + 8);
}

__device__ void phase_prep(CParams& p, char* smem) {
  const int t = threadIdx.x, lane = t & 63, w = t >> 6;
  bf16_t* wsw = (bf16_t*)(p.ws + OFF_W);
  const int N_RMS = NTOK / 4, N_TR = 8128, N_SK = 128, N_UV = 32768, N_ROPE = 129;
  const int TOTAL = N_RMS + N_TR + N_SK + N_UV + N_ROPE;
  for (int it = blockIdx.x; it < TOTAL; it += gridDim.x) {
    int i = it;
    if (i < N_UV) {
      const bool isu = i < 16384;
      const float* src = isu ? p.peer_u + (size_t)i * 2048 : p.peer_v + (size_t)(i - 16384) * 2048;
      unsigned char* dst = (unsigned char*)(p.ws + (isu ? OFF_U : OFF_V)) + (size_t)(i & 16383) * 2048;
      const float sc = isu ? 1024.f : 256.f;
      float4 a = ld_nt4(src + t * 8), b = ld_nt4(src + t * 8 + 4);
      int w0 = __builtin_amdgcn_cvt_pk_fp8_f32(a.x * sc, a.y * sc, 0, false);
      w0 = __builtin_amdgcn_cvt_pk_fp8_f32(a.z * sc, a.w * sc, w0, true);
      int w1 = __builtin_amdgcn_cvt_pk_fp8_f32(b.x * sc, b.y * sc, 0, false);
      w1 = __builtin_amdgcn_cvt_pk_fp8_f32(b.z * sc, b.w * sc, w1, true);
      *(uint2*)(dst + t * 8) = make_uint2((unsigned)w0, (unsigned)w1);
      continue;
    }
    i -= N_UV;
    if (i < N_RMS) {
      int tok = i * 4 + w;
      const float* xr = x_row(p, tok);
      float v[32]; float ss = 0.f;
#pragma unroll
      for (int c = 0; c < 4; c++) {
        float4 a = ld_nt4(xr + c * 512 + lane * 8), b = ld_nt4(xr + c * 512 + lane * 8 + 4);
        v[c * 8 + 0] = a.x; v[c * 8 + 1] = a.y; v[c * 8 + 2] = a.z; v[c * 8 + 3] = a.w;
        v[c * 8 + 4] = b.x; v[c * 8 + 5] = b.y; v[c * 8 + 6] = b.z; v[c * 8 + 7] = b.w;
      }
#pragma unroll
      for (int j = 0; j < 32; j++) ss += v[j] * v[j];
      ss = wave_sum(ss);
      float rs = rsqrtf(ss * (1.f / 2048.f) + EPSF);
      bf16_t* dst = (bf16_t*)(p.ws + OFF_R1) + (size_t)tok * 2048;
#pragma unroll
      for (int c = 0; c < 4; c++) {
        const float* g = p.norm_mix + c * 512 + lane * 8;
        float f[8];
#pragma unroll
        for (int j = 0; j < 8; j++) f[j] = v[c * 8 + j] * rs * g[j];
        *(uint4*)(dst + c * 512 + lane * 8) = pack8(f);
      }
      continue;
    }
    i -= N_RMS;
    if (i < N_TR) {
      const float* src; bf16_t* dst; int K, Nn; const float* ks = nullptr;
      if (i < 3840) { src = p.w_in; dst = wsw + W_IN; K = 2048; Nn = 7680; }
      else if ((i -= 3840) < 512) { src = p.w_proj_rnn; dst = wsw + W_RNN; K = 1024; Nn = 2048; }
      else if ((i -= 512) < 512) { src = p.w_proj_attn; dst = wsw + W_ATT; K = 1024; Nn = 2048; }
      else if ((i -= 512) < 1024) { src = p.w_out; dst = wsw + W_OUT; K = 2048; Nn = 2048; }
      else if ((i -= 1024) < 1024) { src = p.w_peer_q; dst = wsw + W_PQ; K = 2048; Nn = 2048; ks = p.norm_ffn; }
      else if ((i -= 1024) < 128) { src = p.w_ple; dst = wsw + W_PLE; K = 256; Nn = 2048; }
      else if ((i -= 128) < 1024) { src = p.w_ple_gate; dst = wsw + W_GATE; K = 2048; Nn = 2048; }
      else if ((i -= 1024) < 32) { int b = i >> 2; src = p.w_rgate + b * 16384; dst = wsw + W_RG + b * 16384; K = 128; Nn = 128; i &= 3; }
      else { i -= 32; int b = i >> 2; src = p.w_igate + b * 16384; dst = wsw + W_IG + b * 16384; K = 128; Nn = 128; i &= 3; }
      int nkt = K / 64;
      int kt = i % nkt, ntile = i / nkt;
      transpose_tile(src, Nn, dst, K, kt * 64, ntile * 64, ks, smem);
      continue;
    }
    i -= N_TR;
    if (i < N_SK) {
      const float* src = p.sub_keys + (size_t)i * 2048;
      bf16_t* dst = wsw + W_SK + (size_t)i * 2048;
      float4 a = ld_nt4(src + t * 8), b = ld_nt4(src + t * 8 + 4);
      uint4 o; o.x = pack2(a.x, a.y); o.y = pack2(a.z, a.w); o.z = pack2(b.x, b.y); o.w = pack2(b.z, b.w);
      *(uint4*)(dst + t * 8) = o;
      continue;
    }
    i -= N_SK;
    {
      int e = i * 256 + t;
      if (e < 4100 * 8) {
        int pi = e >> 3, fi = e & 7;
        int pos = pi < 4096 ? pi : 16384 + (pi - 4096);
        float inv = powf(500000.f, -(float)fi * 0.125f);
        float ang = (float)pos * inv;
        double tr = (double)ang * 0.15915494309189535;
        tr -= rint(tr);
        float fr = (float)tr;
        float2 cs; cs.x = __builtin_amdgcn_cosf(fr); cs.y = __builtin_amdgcn_sinf(fr);
        ((float2*)(p.ws + OFF_ROPE))[e] = cs;
      }
    }
  }
}

__device__ void phase_gemm1(CParams& p, char* smem) {
  EPI_VARS
  const bf16_t* A = (const bf16_t*)(p.ws + OFF_R1);
  const bf16_t* B = (const bf16_t*)(p.ws + OFF_W) + W_IN;
  bf16_t* zr = (bf16_t*)(p.ws + OFF_ZR);
  bf16_t* zg = (bf16_t*)(p.ws + OFF_ZG);
  const int x = blockIdx.x & 7, per = gridDim.x >> 3;
  if ((int)blockIdx.x >= per * 8) return;
  for (int q = blockIdx.x >> 3;; q += per) {
    int mt, nt;
    if (!tile_at(q, x, 4, 10, 22, 6, mt, nt)) break;
    f32x4 acc[4][6];
    zero_acc6(acc);
    gemm_loop3(acc, A + (size_t)mt * 192 * 2048, 2048, B + (size_t)nt * 128 * 2048, 2048, 2048, smem);
    const int n0 = nt * 128;
    const int act = (n0 < 1024) ? 0 : (n0 < 2048 ? 1 : (n0 < 3584 ? 0 : 2));
    bf16_t* dst; int ld, cb;
    if (n0 < 3584) { dst = zr; ld = 3584; cb = n0; } else { dst = zg; ld = 4096; cb = n0 - 3584; }
    if (act == 2) {
      uint4* gt = (uint4*)zg + ((size_t)(mt * 32 + (nt - 28)) * 12) * 256 + opaque_u(threadIdx.x);
#pragma unroll
      for (int mm = 0; mm < 6; mm++)
#pragma unroll
        for (int n2 = 0; n2 < 2; n2++) {
          uint4 o;
          o.x = pack2(sigmoidf_(acc[2 * n2][mm][0]), sigmoidf_(acc[2 * n2][mm][1]));
          o.y = pack2(sigmoidf_(acc[2 * n2][mm][2]), sigmoidf_(acc[2 * n2][mm][3]));
          o.z = pack2(sigmoidf_(acc[2 * n2 + 1][mm][0]), sigmoidf_(acc[2 * n2 + 1][mm][1]));
          o.w = pack2(sigmoidf_(acc[2 * n2 + 1][mm][2]), sigmoidf_(acc[2 * n2 + 1][mm][3]));
          gt[(mm * 2 + n2) * 256] = o;
        }
    } else {
      bf16_t* dt = dst + (size_t)mt * 192 * ld + cb;
      bf16_t (*T)[136] = (bf16_t (*)[136])smem;
      __syncthreads();
      const unsigned lrow = opaque_u(LROW3), lcol = opaque_u(LCOL8);
#pragma unroll
      for (int mm = 0; mm < 6; mm++)
#pragma unroll
        for (int g = 0; g < 2; g++) {
          float v[8];
#pragma unroll
          for (int j = 0; j < 4; j++) { v[j] = acc[2 * g][mm][j]; v[4 + j] = acc[2 * g + 1][mm][j]; }
          if (act == 1) {
#pragma unroll
            for (int j = 0; j < 8; j++) v[j] = gelu_tanh(v[j]);
          }
          *(uint4*)&T[lrow + mm * 16][lcol + g * 32] = pack8(v);
        }
      __syncthreads();
      const unsigned tt = opaque_u(threadIdx.x);
#pragma unroll
      for (int i = 0; i < 12; i++) {
        const unsigned c = tt + 256u * i, row = c >> 4, ch = (c & 15u) * 8u;
        *(uint4*)(dt + (size_t)row * ld + ch) = *(const uint4*)&T[row][ch];
      }
    }
  }
}

__device__ void rglru_tile(CParams& p, int mt, int jb, char* smem) {
  EPI_VARS
  bf16_t (*A2)[136] = (bf16_t (*)[136])smem;
  bf16_t (*B2)[136] = (bf16_t (*)[136])(smem + 34816);
  const bf16_t* zr = (const bf16_t*)(p.ws + OFF_ZR);
  const bf16_t* wsw = (const bf16_t*)(p.ws + OFF_W);
  float* a_arr = p.out;
  float* b_arr = p.out + (size_t)NTOK * 1024;
  const int t = threadIdx.x;
  const int c8 = (t & 15) * 8, r0 = t >> 4, ch0 = jb * 128 + c8;
  float cw[4][8], cbias[8];
#pragma unroll
  for (int k = 0; k < 4; k++)
#pragma unroll
    for (int j = 0; j < 8; j++) cw[k][j] = p.conv_w[k * 1024 + ch0 + j];
#pragma unroll
  for (int j = 0; j < 8; j++) cbias[j] = p.conv_b[ch0 + j];
  __syncthreads();
  for (int i = 0; i < 8; i++) {
    int r = r0 + 16 * i, tok = mt * 128 + r;
    float xc[8];
#pragma unroll
    for (int j = 0; j < 8; j++) xc[j] = cbias[j];
#pragma unroll
    for (int d = 0; d < 4; d++) {
      float xv[8];
      bool fromz, zero = false;
      int sidx = 0;
      if (tok < NPROMPT) { fromz = ((tok & 4095) >= d); zero = !fromz; }
      else { int s = tok - NPROMPT, dt = s & 3; fromz = (dt >= d); sidx = ((s >> 2) * 3 + (3 + dt - d)); }
      if (fromz) {
        uint4 u = *(const uint4*)(zr + (size_t)(tok - d) * 3584 + ch0);
        unpack8(u, xv);
      } else if (zero) {
#pragma unroll
        for (int j = 0; j < 8; j++) xv[j] = 0.f;
      } else {
        const float* sp = p.state_conv + (size_t)sidx * 1024 + ch0;
#pragma unroll
        for (int j = 0; j < 8; j++) xv[j] = sp[j];
      }
      if (d == 0) {
        if (tok < NPROMPT) {
          int ts = tok & 4095;
          if (ts >= 4093) {
            float* o = p.out + O_PCONV + (size_t)((tok >> 12) * 3 + (ts - 4093)) * 1024 + ch0;
#pragma unroll
            for (int j = 0; j < 8; j++) o[j] = xv[j];
          }
        } else {
          int s = tok - NPROMPT, dt = s & 3;
          if (dt >= 1) {
            float* o = p.out + O_SCONV + (size_t)((s >> 2) * 3 + (dt - 1)) * 1024 + ch0;
#pragma unroll
            for (int j = 0; j < 8; j++) o[j] = xv[j];
          }
        }
      }
#pragma unroll
      for (int j = 0; j < 8; j++) xc[j] += cw[3 - d][j] * xv[j];
    }
    *(uint4*)&A2[r][c8] = pack8(xc);
  }
  load_b2(B2, wsw + W_RG + jb * 16384);
  __syncthreads();
  f32x16 accr[2][2], acci[2][2];
  zero_acc(accr); zero_acc(acci);
  lds_gemm128(accr, A2, B2);
  __syncthreads();
  load_b2(B2, wsw + W_IG + jb * 16384);
  __syncthreads();
  lds_gemm128(acci, A2, B2);
  float* sumP = (float*)(p.ws + OFF_SUM);
  float* sumH = sumP + 524288;
  const int hh = lane >> 5;
#pragma unroll
  for (int j = 0; j < 2; j++) {
    int col = ACC_COL(j), ch = jb * 128 + col;
    float br = p.b_rgate[ch], bi = p.b_igate[ch];
    float sp = log1pf(__expf(-p.lru_lambda[ch]));
#pragma unroll
    for (int i = 0; i < 2; i++) {
      float Pq[4], Hq[4];
#pragma unroll
      for (int r = 0; r < 16; r++) {
        int row = ACC_ROW(i, r), tok = mt * 128 + row;
        float xcv = bf2f(A2[row][col]);
        float rg = __builtin_amdgcn_rcpf(1.f + __expf(-(accr[i][j][r] + br)));
        float ig = __builtin_amdgcn_rcpf(1.f + __expf(-(acci[i][j][r] + bi)));
        float la = -8.f * rg * sp;
        float a = __expf(la);
        float mult = (tok < NPROMPT && (tok & 4095) == 0) ? 1.f : sqrtf(fmaxf(1.f - a * a, 0.f));
        float bv = mult * ig * xcv;
        a_arr[(size_t)tok * 1024 + ch] = a;
        b_arr[(size_t)tok * 1024 + ch] = bv;
        if ((r & 3) == 0) { Pq[r >> 2] = a; Hq[r >> 2] = bv; }
        else { Pq[r >> 2] *= a; Hq[r >> 2] = Hq[r >> 2] * a + bv; }
      }
      if (mt < 128) {
        float P = 1.f, H = 0.f;
#pragma unroll
        for (int q = 0; q < 4; q++) {
          float Pp = __shfl_xor(Pq[q], 32), Hp = __shfl_xor(Hq[q], 32);
          float P1 = hh ? Pp : Pq[q], H1 = hh ? Hp : Hq[q];
          float P2 = hh ? Pq[q] : Pp, H2 = hh ? Hq[q] : Hp;
          H = H * P1 + H1; P *= P1;
          H = H * P2 + H2; P *= P2;
        }
        if (hh == 0) {
          int cid = mt * 4 + wm * 2 + i;
          sumP[(size_t)cid * 1024 + ch] = P;
          sumH[(size_t)cid * 1024 + ch] = H;
        }
      }
    }
  }
}

__device__ void attn_prompt_item(CParams& p, int b, int nb, int kvh, char* smem) {
  const int t = threadIdx.x, lane = t & 63, w = t >> 6;
  bf16_t (*Ks)[72] = (bf16_t (*)[72])smem;
  bf16_t (*Vt)[264] = (bf16_t (*)[264])(smem + 36864);
  const bf16_t* zr = (const bf16_t*)(p.ws + OFF_ZR);
  const float2* rope = (const float2*)(p.ws + OFF_ROPE);
  bf16_t* obuf = (bf16_t*)(p.ws + OFF_R1) + (size_t)NTOK * 1024;
  __syncthreads();
  {
    int jk = t;
    int ts = (nb - 1) * 128 + jk;
    if (ts >= 0) {
      int tok = b * 4096 + ts;
      const bf16_t* kp = zr + (size_t)tok * 3584 + 3072 + kvh * 64;
      const bf16_t* vp = zr + (size_t)tok * 3584 + 3328 + kvh * 64;
      const bool wout = (nb == 31 && jk >= 128);
      float* ok = p.out + O_PK + (size_t)((b * 128 + (jk - 128)) * 4 + kvh) * 64;
      float* ov = p.out + O_PV + (size_t)((b * 128 + (jk - 128)) * 4 + kvh) * 64;
      uint4 k0 = *(const uint4*)(kp), k1 = *(const uint4*)(kp + 8), k2 = *(const uint4*)(kp + 16), k3 = *(const uint4*)(kp + 24);
      uint4 k4 = *(const uint4*)(kp + 32), k5 = *(const uint4*)(kp + 40), k6 = *(const uint4*)(kp + 48), k7 = *(const uint4*)(kp + 56);
      float ss = 0.f;
#define SSQ8(u) { float f_[8]; unpack8(u, f_); for (int j_ = 0; j_ < 8; j_++) ss += f_[j_] * f_[j_]; }
      SSQ8(k0) SSQ8(k1) SSQ8(k2) SSQ8(k3) SSQ8(k4) SSQ8(k5) SSQ8(k6) SSQ8(k7)
      const float rs = rsqrtf(ss * (1.f / 64.f) + EPSF);
      {
        float f0[8], f1[8];
        unpack8(k0, f0); unpack8(k1, f1);
#pragma unroll
        for (int i = 0; i < 8; i++) {
          float x1 = f0[i] * rs * p.k_norm[i], x2 = f1[i] * rs * p.k_norm[8 + i];
          float2 cs = rope[ts * 8 + i];
          f0[i] = x1 * cs.x - x2 * cs.y;
          f1[i] = x2 * cs.x + x1 * cs.y;
        }
        *(uint4*)&Ks[jk][0] = pack8(f0);
        *(uint4*)&Ks[jk][8] = pack8(f1);
        if (wout) {
          *(float4*)(ok + 0) = make_float4(f0[0], f0[1], f0[2], f0[3]); *(float4*)(ok + 4) = make_float4(f0[4], f0[5], f0[6], f0[7]);
          *(float4*)(ok + 8) = make_float4(f1[0], f1[1], f1[2], f1[3]); *(float4*)(ok + 12) = make_float4(f1[4], f1[5], f1[6], f1[7]);
        }
      }
#define KREST(u, c) { float f_[8]; unpack8(u, f_); for (int j_ = 0; j_ < 8; j_++) f_[j_] = f_[j_] * rs * p.k_norm[(c) * 8 + j_]; \
        *(uint4*)&Ks[jk][(c) * 8] = pack8(f_); \
        if (wout) { *(float4*)(ok + (c) * 8) = make_float4(f_[0], f_[1], f_[2], f_[3]); *(float4*)(ok + (c) * 8 + 4) = make_float4(f_[4], f_[5], f_[6], f_[7]); } }
      KREST(k2, 2) KREST(k3, 3) KREST(k4, 4) KREST(k5, 5) KREST(k6, 6) KREST(k7, 7)
#pragma unroll 2
      for (int c = 0; c < 8; c++) {
        uint4 u = *(const uint4*)(vp + c * 8);
        Vt[c * 8 + 0][jk] = (bf16_t)(u.x & 0xffffu); Vt[c * 8 + 1][jk] = (bf16_t)(u.x >> 16);
        Vt[c * 8 + 2][jk] = (bf16_t)(u.y & 0xffffu); Vt[c * 8 + 3][jk] = (bf16_t)(u.y >> 16);
        Vt[c * 8 + 4][jk] = (bf16_t)(u.z & 0xffffu); Vt[c * 8 + 5][jk] = (bf16_t)(u.z >> 16);
        Vt[c * 8 + 6][jk] = (bf16_t)(u.w & 0xffffu); Vt[c * 8 + 7][jk] = (bf16_t)(u.w >> 16);
        if (wout) {
          float f_[8]; unpack8(u, f_);
          *(float4*)(ov + c * 8) = make_float4(f_[0], f_[1], f_[2], f_[3]); *(float4*)(ov + c * 8 + 4) = make_float4(f_[4], f_[5], f_[6], f_[7]);
        }
      }
    } else {
      uint4 z4 = make_uint4(0, 0, 0, 0);
#pragma unroll
      for (int c = 0; c < 8; c++) *(uint4*)&Ks[jk][c * 8] = z4;
#pragma unroll
      for (int d = 0; d < 64; d++) Vt[d][jk] = 0;
    }
  }
  __syncthreads();
  const int r = lane & 31, h = lane >> 5;
  const int iq = 32 * w + r;
  const int tsq = nb * 128 + iq;
  const int tokq = b * 4096 + tsq;
#pragma unroll 1
  for (int g = 0; g < 4; g++) {
    asm volatile("" ::: "memory");
    const int qh = kvh * 4 + g;
    float qf[4][8];
    const bf16_t* qp = zr + (size_t)tokq * 3584 + 2048 + qh * 64 + 8 * h;
    float ss = 0.f;
#pragma unroll
    for (int kk = 0; kk < 4; kk++) {
      uint4 u = *(const uint4*)(qp + kk * 16);
      unpack8(u, qf[kk]);
#pragma unroll
      for (int j = 0; j < 8; j++) ss += qf[kk][j] * qf[kk][j];
    }
    ss += __shfl_xor(ss, 32);
    float rs = rsqrtf(ss * (1.f / 64.f) + EPSF);
#pragma unroll
    for (int kk = 0; kk < 4; kk++)
#pragma unroll
      for (int j = 0; j < 8; j++) qf[kk][j] = qf[kk][j] * rs * p.q_norm[kk * 16 + 8 * h + j];
#pragma unroll
    for (int j = 0; j < 8; j++) {
      float2 cs = rope[tsq * 8 + j];
      float mine = qf[0][j];
      float other = __shfl_xor(mine, 32);
      qf[0][j] = (h == 0) ? (mine * cs.x - other * cs.y) : (mine * cs.x + other * cs.y);
    }
    bf16x8 bq[4];
#pragma unroll
    for (int kk = 0; kk < 4; kk++) {
      float f[8];
#pragma unroll
      for (int j = 0; j < 8; j++) f[j] = qf[kk][j] * 0.125f;
      uint4 u = pack8(f);
      bq[kk] = *(bf16x8*)&u;
    }
    f32x16 s[5];
#pragma unroll
    for (int kt = 0; kt < 5; kt++) {
#pragma unroll
      for (int e = 0; e < 16; e++) s[kt][e] = 0.f;
#pragma unroll
      for (int kk = 0; kk < 4; kk++) {
        bf16x8 a = *(const bf16x8*)&Ks[32 * (w + kt) + r][kk * 16 + 8 * h];
        s[kt] = __builtin_amdgcn_mfma_f32_32x32x16_bf16(a, bq[kk], s[kt], 0, 0, 0);
      }
    }
    const float sink = p.attn_sinks[qh];
    float m = -3e38f;
#pragma unroll
    for (int e = 0; e < 16; e++) {
      int jr = (e & 3) + 8 * (e >> 2) + 4 * h;
      s[0][e] = (jr > r) ? s[0][e] : -1e30f;
      s[4][e] = (jr <= r) ? s[4][e] : -1e30f;
    }
    if (nb == 0) {
#pragma unroll
      for (int kt = 0; kt < 4; kt++)
        if (w + kt < 4) {
#pragma unroll
          for (int e = 0; e < 16; e++) s[kt][e] = -1e30f;
        }
    }
#pragma unroll
    for (int kt = 0; kt < 5; kt++)
#pragma unroll
      for (int e = 0; e < 16; e++) m = fmaxf(m, s[kt][e]);
    m = fmaxf(m, __shfl_xor(m, 32));
    m = fmaxf(m, sink);
    float l = 0.f;
#pragma unroll
    for (int kt = 0; kt < 5; kt++)
#pragma unroll
      for (int e = 0; e < 16; e++) { float pv = __expf(s[kt][e] - m); s[kt][e] = pv; l += pv; }
    l += __shfl_xor(l, 32);
    l += __expf(sink - m);
    const float linv = 1.f / l;
    f32x16 o[2];
#pragma unroll
    for (int e = 0; e < 16; e++) { o[0][e] = 0.f; o[1][e] = 0.f; }
#pragma unroll
    for (int kt = 0; kt < 5; kt++)
#pragma unroll
      for (int u2 = 0; u2 < 2; u2++) {
        float f[8];
#pragma unroll
        for (int j = 0; j < 8; j++) f[j] = s[kt][8 * u2 + j];
        uint4 pu = pack8(f);
        bf16x8 pb = *(bf16x8*)&pu;
        int kb = 32 * (w + kt) + 16 * u2 + 4 * h;
#pragma unroll
        for (int dt = 0; dt < 2; dt++) {
          uint2 v0 = *(const uint2*)&Vt[32 * dt + r][kb];
          uint2 v1 = *(const uint2*)&Vt[32 * dt + r][kb + 8];
          uint4 va = make_uint4(v0.x, v0.y, v1.x, v1.y);
          o[dt] = __builtin_amdgcn_mfma_f32_32x32x16_bf16(*(bf16x8*)&va, pb, o[dt], 0, 0, 0);
        }
      }
    bf16_t* op = obuf + (size_t)tokq * 1024 + qh * 64;
#pragma unroll
    for (int dt = 0; dt < 2; dt++)
#pragma unroll
      for (int e4 = 0; e4 < 4; e4++) {
        int d = 32 * dt + 8 * e4 + 4 * h;
        uint2 st;
        st.x = pack2(o[dt][4 * e4 + 0] * linv, o[dt][4 * e4 + 1] * linv);
        st.y = pack2(o[dt][4 * e4 + 2] * linv, o[dt][4 * e4 + 3] * linv);
        *(uint2*)(op + d) = st;
      }
  }
}

__device__ void attn_sample_item(CParams& p, int db, char* smem) {
  const int t = threadIdx.x, lane = t & 63, w = t >> 6;
  const int kvh = w;
  float* qs = (float*)smem + w * 1024;
  float* knew = (float*)smem + 4096 + w * 256;
  float* vnew = (float*)smem + 5120 + w * 256;
  float* ps = (float*)smem + 6144 + w * (16 * 132);
  const bf16_t* zr = (const bf16_t*)(p.ws + OFF_ZR);
  const float2* rope = (const float2*)(p.ws + OFF_ROPE);
  bf16_t* obuf = (bf16_t*)(p.ws + OFF_R1) + (size_t)NTOK * 1024;
  const int tok0 = NPROMPT + db * 4;
  __syncthreads();
  {
    int row = lane >> 4, part = lane & 15, d0 = part * 4;
    const bf16_t* kp = zr + (size_t)(tok0 + row) * 3584 + 3072 + kvh * 64 + d0;
    const bf16_t* vp = zr + (size_t)(tok0 + row) * 3584 + 3328 + kvh * 64 + d0;
    uint2 ku = *(const uint2*)kp, vu = *(const uint2*)vp;
    float kf[4] = {lo2f(ku.x), hi2f(ku.x), lo2f(ku.y), hi2f(ku.y)};
    float vf[4] = {lo2f(vu.x), hi2f(vu.x), lo2f(vu.y), hi2f(vu.y)};
    float ss = kf[0] * kf[0] + kf[1] * kf[1] + kf[2] * kf[2] + kf[3] * kf[3];
    ss += __shfl_xor(ss, 1); ss += __shfl_xor(ss, 2); ss += __shfl_xor(ss, 4); ss += __shfl_xor(ss, 8);
    float rs = rsqrtf(ss * (1.f / 64.f) + EPSF);
#pragma unroll
    for (int j = 0; j < 4; j++) kf[j] = kf[j] * rs * p.k_norm[d0 + j];
#pragma unroll
    for (int j = 0; j < 4; j++) {
      float other = __shfl_xor(kf[j], 2);
      if (part < 4) {
        float2 cs = rope[(4096 + row) * 8 + ((d0 + j) & 7)];
        kf[j] = (part < 2) ? (kf[j] * cs.x - other * cs.y) : (kf[j] * cs.x + other * cs.y);
      }
    }
    float* ok = p.out + O_SK + (size_t)((db * 128 + 124 + row) * 4 + kvh) * 64 + d0;
    float* ov = p.out + O_SV + (size_t)((db * 128 + 124 + row) * 4 + kvh) * 64 + d0;
#pragma unroll
    for (int j = 0; j < 4; j++) { knew[row * 64 + d0 + j] = kf[j]; vnew[row * 64 + d0 + j] = vf[j]; ok[j] = kf[j]; ov[j] = vf[j]; }
  }
  {
    int qrow = lane >> 2, part = lane & 3, g = qrow >> 2, tq = qrow & 3, d0 = part * 16;
    int qh = kvh * 4 + g;
    const bf16_t* qp = zr + (size_t)(tok0 + tq) * 3584 + 2048 + qh * 64 + d0;
    float qf[16];
    unpack8(*(const uint4*)qp, qf); unpack8(*(const uint4*)(qp + 8), qf + 8);
    float ss = 0.f;
#pragma unroll
    for (int j = 0; j < 16; j++) ss += qf[j] * qf[j];
    ss += __shfl_xor(ss, 1); ss += __shfl_xor(ss, 2);
    float rs = rsqrtf(ss * (1.f / 64.f) + EPSF);
#pragma unroll
    for (int j = 0; j < 16; j++) qf[j] = qf[j] * rs * p.q_norm[d0 + j];
    if (part == 0) {
#pragma unroll
      for (int i = 0; i < 8; i++) {
        float2 cs = rope[(4096 + tq) * 8 + i];
        float x1 = qf[i], x2 = qf[i + 8];
        qf[i] = x1 * cs.x - x2 * cs.y;
        qf[i + 8] = x2 * cs.x + x1 * cs.y;
      }
    }
#pragma unroll
    for (int j = 0; j < 16; j++) qs[qrow * 64 + d0 + j] = qf[j] * 0.125f;
  }
  __syncthreads();
#pragma unroll 1
  for (int sl = 0; sl < 3; sl++) {
    int j = lane + 64 * sl;
    if (j < 132) {
      float scq[16];
#pragma unroll
      for (int q = 0; q < 16; q++) scq[q] = 0.f;
      const float* kr = (j < 128) ? p.cache_k + (size_t)((db * 128 + j) * 4 + kvh) * 64 : knew + (j - 128) * 64;
#pragma unroll 2
      for (int d = 0; d < 64; d += 4) {
        float4 kv = *(const float4*)(kr + d);
        if (j >= 4 && j < 128) *(float4*)(p.out + O_SK + (size_t)((db * 128 + j - 4) * 4 + kvh) * 64 + d) = kv;
#pragma unroll
        for (int q = 0; q < 16; q++) {
          float4 qv = *(const float4*)(qs + q * 64 + d);
          scq[q] += kv.x * qv.x + kv.y * qv.y + kv.z * qv.z + kv.w * qv.w;
        }
      }
#pragma unroll
      for (int q = 0; q < 16; q++) ps[q * 132 + j] = scq[q];
    }
  }
#pragma unroll 1
  for (int q = 0; q < 16; q++) {
    int g = q >> 2, tq = q & 3;
    float sink = p.attn_sinks[kvh * 4 + g];
    float m = -3e38f;
    float sv[3];
#pragma unroll
    for (int sl = 0; sl < 3; sl++) {
      int j = lane + 64 * sl;
      bool valid = (j < 132) && (j >= tq + 1) && (j <= tq + 128);
      float v = valid ? ps[q * 132 + j] : -1e30f;
      sv[sl] = v;
      m = fmaxf(m, v);
    }
    m = fmaxf(wave_max(m), sink);
    float l = 0.f;
#pragma unroll
    for (int sl = 0; sl < 3; sl++) { float pv = __expf(sv[sl] - m); sv[sl] = pv; l += pv; }
    l = wave_sum(l) + __expf(sink - m);
    float linv = 1.f / l;
#pragma unroll
    for (int sl = 0; sl < 3; sl++) {
      int j = lane + 64 * sl;
      if (j < 132) ps[q * 132 + j] = sv[sl] * linv;
    }
  }
  __syncthreads();
  float oacc[16];
#pragma unroll
  for (int q = 0; q < 16; q++) oacc[q] = 0.f;
  for (int j = 0; j < 132; j++) {
    float vv;
    if (j < 128) {
      vv = p.cache_v[(size_t)((db * 128 + j) * 4 + kvh) * 64 + lane];
      if (j >= 4) p.out[O_SV + (size_t)((db * 128 + j - 4) * 4 + kvh) * 64 + lane] = vv;
    } else vv = vnew[(j - 128) * 64 + lane];
#pragma unroll
    for (int q = 0; q < 16; q++) oacc[q] += ps[q * 132 + j] * vv;
  }
#pragma unroll
  for (int q = 0; q < 16; q++) {
    int g = q >> 2, tq = q & 3;
    obuf[(size_t)(tok0 + tq) * 1024 + (kvh * 4 + g) * 64 + lane] = f2bf(oacc[q]);
  }
}

#ifndef ONLY2
#define ONLY2 -1
#endif
#define P2_ON(n) (true)
__device__ void phase_mix(CParams& p, char* smem) {
  if (P2_ON(0))
    for (int it = blockIdx.x; it < 512; it += gridDim.x) {
      CParams& q = *get_params();
      attn_prompt_item(q, it >> 7, (it >> 2) & 31, it & 3, smem);
    }
  if (P2_ON(1))
    for (int it = blockIdx.x; it < 1056; it += gridDim.x) {
      CParams& q = *get_params();
      rglru_tile(q, it >> 3, it & 7, smem);
    }
  if (P2_ON(2))
    for (int it = (int)gridDim.x - 1 - (int)blockIdx.x; it < 128; it += gridDim.x) {
      CParams& q = *get_params();
      attn_sample_item(q, it, smem);
    }
}

__device__ void phase_scan1(CParams& p) {}
__device__ void phase_scan2(CParams& p) {
  const float* a_arr = p.out;
  const float* b_arr = p.out + (size_t)NTOK * 1024;
  const float* sumP = (const float*)(p.ws + OFF_SUM);
  const float* sumH = sumP + 524288;
  const bf16_t* zr = (const bf16_t*)(p.ws + OFF_ZR);
  bf16_t* hg = (bf16_t*)(p.ws + OFF_R1);
  for (int it = blockIdx.x; it < 512 + 512; it += gridDim.x) {
    if (it < 512) {
      int id = it * 256 + threadIdx.x;
      int ch = id & 1023, cg = (id >> 10) & 31, b = id >> 15;
      float h = 0.f;
      const float* sp = sumP + (size_t)(b * 128) * 1024 + ch;
      const float* sh = sumH + (size_t)(b * 128) * 1024 + ch;
      {
        const int nprev = cg * 4;
        int c = 0;
        for (; c + 16 <= nprev; c += 16) {
          float pp[16], ph_[16];
#pragma unroll
          for (int u = 0; u < 16; u++) { pp[u] = sp[(size_t)(c + u) * 1024]; ph_[u] = sh[(size_t)(c + u) * 1024]; }
#pragma unroll
          for (int u = 0; u < 16; u++) h = pp[u] * h + ph_[u];
        }
        for (; c < nprev; c++) h = sp[(size_t)c * 1024] * h + sh[(size_t)c * 1024];
      }
#pragma unroll 1
      for (int sub = 0; sub < 4; sub++) {
        size_t tok0 = (size_t)b * 4096 + (cg * 4 + sub) * 32;
        float av[32], bv[32], gv[32];
#pragma unroll
        for (int s2 = 0; s2 < 32; s2++) {
          size_t tok = tok0 + s2;
          av[s2] = a_arr[tok * 1024 + ch];
          bv[s2] = b_arr[tok * 1024 + ch];
          gv[s2] = bf2f(zr[tok * 3584 + 1024 + ch]);
        }
#pragma unroll
        for (int s2 = 0; s2 < 32; s2++) {
          h = av[s2] * h + bv[s2];
          hg[(tok0 + s2) * 1024 + ch] = f2bf(h * gv[s2]);
        }
      }
      if (cg == 31) p.out[O_PRG + b * 1024 + ch] = h;
    } else {
      int id = (it - 512) * 256 + threadIdx.x;
      int ch = id & 1023, db = id >> 10;
      float h = p.state_rglru[db * 1024 + ch];
#pragma unroll
      for (int dt = 0; dt < 4; dt++) {
        size_t tok = NPROMPT + db * 4 + dt;
        h = a_arr[tok * 1024 + ch] * h + b_arr[tok * 1024 + ch];
        float gg = bf2f(zr[tok * 3584 + 1024 + ch]);
        hg[tok * 1024 + ch] = f2bf(h * gg);
      }
      p.out[O_SRG + db * 1024 + ch] = h;
    }
  }
}

__device__ void phase_proj(CParams& p, char* smem) {
  EPI_VARS
  const bf16_t* hg = (const bf16_t*)(p.ws + OFF_R1);
  const bf16_t* ob = hg + (size_t)NTOK * 1024;
  const bf16_t* wsw = (const bf16_t*)(p.ws + OFF_W);
  const bf16_t* zg = (const bf16_t*)(p.ws + OFF_ZG);
  bf16_t* merged = (bf16_t*)(p.ws + OFF_ZR);
  const int x = blockIdx.x & 7, per = gridDim.x >> 3;
  if ((int)blockIdx.x >= per * 8) return;
  for (int q = blockIdx.x >> 3;; q += per) {
    int mt, nt;
    if (!tile_at(q, x, 1, 16, 88, 1, mt, nt)) break;
    f32x4 acc[4][6];
    zero_acc6(acc);
    gemm_loop3(acc, hg + (size_t)mt * 192 * 1024, 1024, wsw + W_RNN + (size_t)nt * 128 * 1024, 1024, 1024, smem);
    {
    const uint4* gat = (const uint4*)zg + ((size_t)(mt * 32 + nt) * 12) * 256 + opaque_u(threadIdx.x);
    uint4* ptl = (uint4*)p.out + ((size_t)(mt * 16 + nt) * 12) * 256 + opaque_u(threadIdx.x);
#pragma unroll
    for (int mm = 0; mm < 6; mm++)
#pragma unroll
      for (int n2 = 0; n2 < 2; n2++) {
        const uint4 g = gat[(mm * 2 + n2) * 256];
        uint4 o;
        o.x = pack2(acc[2 * n2][mm][0] * lo2f(g.x), acc[2 * n2][mm][1] * hi2f(g.x));
        o.y = pack2(acc[2 * n2][mm][2] * lo2f(g.y), acc[2 * n2][mm][3] * hi2f(g.y));
        o.z = pack2(acc[2 * n2 + 1][mm][0] * lo2f(g.z), acc[2 * n2 + 1][mm][1] * hi2f(g.z));
        o.w = pack2(acc[2 * n2 + 1][mm][2] * lo2f(g.w), acc[2 * n2 + 1][mm][3] * hi2f(g.w));
        ptl[(mm * 2 + n2) * 256] = o;
      }
    }
    zero_acc6(acc);
    gemm_loop3(acc, ob + (size_t)mt * 192 * 1024, 1024, wsw + W_ATT + (size_t)nt * 128 * 1024, 1024, 1024, smem);
    asm volatile("" ::: "memory");
    {
      bf16_t (*T)[136] = (bf16_t (*)[136])smem;
      __syncthreads();
      const uint4* gbt = (const uint4*)zg + ((size_t)(mt * 32 + 16 + nt) * 12) * 256 + opaque_u(threadIdx.x);
      const uint4* ptl = (const uint4*)p.out + ((size_t)(mt * 16 + nt) * 12) * 256 + opaque_u(threadIdx.x);
      bf16_t* mgt = merged + (size_t)mt * 192 * 2048 + nt * 128;
      const unsigned lrow = opaque_u(LROW3), lcol = opaque_u(LCOL8);
#pragma unroll
      for (int mm = 0; mm < 6; mm++)
#pragma unroll
        for (int n2 = 0; n2 < 2; n2++) {
          const uint4 g = gbt[(mm * 2 + n2) * 256];
          const uint4 pm = ptl[(mm * 2 + n2) * 256];
          uint4 o;
          o.x = pack2(lo2f(pm.x) + acc[2 * n2][mm][0] * lo2f(g.x), hi2f(pm.x) + acc[2 * n2][mm][1] * hi2f(g.x));
          o.y = pack2(lo2f(pm.y) + acc[2 * n2][mm][2] * lo2f(g.y), hi2f(pm.y) + acc[2 * n2][mm][3] * hi2f(g.y));
          o.z = pack2(lo2f(pm.z) + acc[2 * n2 + 1][mm][0] * lo2f(g.z), hi2f(pm.z) + acc[2 * n2 + 1][mm][1] * hi2f(g.z));
          o.w = pack2(lo2f(pm.w) + acc[2 * n2 + 1][mm][2] * lo2f(g.w), hi2f(pm.w) + acc[2 * n2 + 1][mm][3] * hi2f(g.w));
          *(uint4*)&T[lrow + mm * 16][lcol + n2 * 32] = o;
        }
      __syncthreads();
      const unsigned tt = opaque_u(threadIdx.x);
#pragma unroll
      for (int i = 0; i < 12; i++) {
        const unsigned c = tt + 256u * i, row = c >> 4, ch = (c & 15u) * 8u;
        *(uint4*)(mgt + (size_t)row * 2048 + ch) = *(const uint4*)&T[row][ch];
      }
    }
  }
}

__device__ void phase_wout(CParams& p, char* smem) {
  EPI_VARS
  const bf16_t* merged = (const bf16_t*)(p.ws + OFF_ZR);
  const bf16_t* wsw = (const bf16_t*)(p.ws + OFF_W);
  bf16_t* x1b = (bf16_t*)(p.ws + OFF_R1);
  const int x = blockIdx.x & 7, per = gridDim.x >> 3;
  if ((int)blockIdx.x >= per * 8) return;
  for (int q = blockIdx.x >> 3;; q += per) {
    int mt, nt;
    if (!tile_at(q, x, 1, 16, 88, 1, mt, nt)) break;
    f32x4 acc[4][6];
    zero_acc6(acc);
    gemm_loop3(acc, merged + (size_t)mt * 192 * 2048, 2048, wsw + W_OUT + (size_t)nt * 128 * 2048, 2048, 2048, smem);
    asm volatile("" ::: "memory");
    float* yt = p.out + O_Y + (size_t)mt * 192 * 2048 + nt * 128;
    bf16_t* xbt = x1b + (size_t)mt * 192 * 2048 + nt * 128;
    const unsigned lo = opaque_u(LROW3 * 2048 + LCOL8);
    const int colx = nt * 128 + LCOL8;
    bf16_t (*T)[136] = (bf16_t (*)[136])smem;
    __syncthreads();
    const unsigned lrow = opaque_u(LROW3), lcol = opaque_u(LCOL8);
#pragma unroll
    for (int mm = 0; mm < 6; mm++) {
      const float* xr = x_row(p, mt * 192 + LROW3 + mm * 16) + colx;
#pragma unroll
      for (int g = 0; g < 2; g++) {
        unsigned o = lo + (unsigned)(mm * 16 * 2048 + g * 32);
        float4 xa = *(const float4*)(xr + g * 32), xb = *(const float4*)(xr + g * 32 + 4);
        float4 va = make_float4(xa.x + acc[2 * g][mm][0], xa.y + acc[2 * g][mm][1], xa.z + acc[2 * g][mm][2], xa.w + acc[2 * g][mm][3]);
        float4 vb = make_float4(xb.x + acc[2 * g + 1][mm][0], xb.y + acc[2 * g + 1][mm][1], xb.z + acc[2 * g + 1][mm][2], xb.w + acc[2 * g + 1][mm][3]);
        *(float4*)(yt + o) = va;
        *(float4*)(yt + o + 4) = vb;
        *(uint4*)&T[lrow + mm * 16][lcol + g * 32] = make_uint4(pack2(va.x, va.y), pack2(va.z, va.w), pack2(vb.x, vb.y), pack2(vb.z, vb.w));
      }
    }
    __syncthreads();
    const unsigned tt = opaque_u(threadIdx.x);
#pragma unroll
    for (int i = 0; i < 12; i++) {
      const unsigned c = tt + 256u * i, row = c >> 4, ch = (c & 15u) * 8u;
      *(uint4*)(xbt + (size_t)row * 2048 + ch) = *(const uint4*)&T[row][ch];
    }
  }
}

__device__ void phase_pq(CParams& p, char* smem) {
  EPI_VARS
  const bf16_t* x1b = (const bf16_t*)(p.ws + OFF_R1);
  const bf16_t* wsw = (const bf16_t*)(p.ws + OFF_W);
  float* scores = (float*)(p.ws + OFF_ZG);
  bf16_t (*A2)[136] = (bf16_t (*)[136])smem;
  bf16_t (*B2)[136] = (bf16_t (*)[136])(smem + 34816);
  const int x = blockIdx.x & 7, per = gridDim.x >> 3;
  if ((int)blockIdx.x >= per * 8) return;
  for (int q = blockIdx.x >> 3;; q += per) {
    int mt, nt;
    if (!tile_at(q, x, 1, 16, 132, 1, mt, nt)) break;
    {
      f32x4 acc4[4][4];
      zero_acc4(acc4);
      gemm_loop(acc4, x1b + (size_t)mt * 128 * 2048, 2048, wsw + W_PQ + (size_t)nt * 128 * 2048, 2048, 2048, smem);
      __syncthreads();
#pragma unroll
      for (int mm = 0; mm < 4; mm++)
#pragma unroll
        for (int nn = 0; nn < 4; nn++)
          *(uint2*)&A2[LROW2 + mm * 16][LCOL2 + nn * 16] =
              make_uint2(pack2(acc4[nn][mm][0], acc4[nn][mm][1]), pack2(acc4[nn][mm][2], acc4[nn][mm][3]));
    }
    load_b2(B2, wsw + W_SK + (size_t)nt * 16384);
    __syncthreads();
    f32x16 acc[2][2];
    zero_acc(acc);
    lds_gemm128(acc, A2, B2);
    float* sct = scores + (size_t)mt * 128 * 2048 + nt * 128;
    float (*S)[132] = (float (*)[132])smem;
    __syncthreads();
    {
      const unsigned lrow = opaque_u(LROW), lcol = opaque_u(LCOL);
#pragma unroll
      for (int i = 0; i < 2; i++)
#pragma unroll
        for (int j = 0; j < 2; j++)
#pragma unroll
          for (int r = 0; r < 16; r++) S[lrow + ROWC(i, r)][lcol + j * 32] = acc[i][j][r];
    }
    __syncthreads();
    {
      const unsigned tt = opaque_u(threadIdx.x);
#pragma unroll
      for (int i = 0; i < 16; i++) {
        const unsigned c = tt + 256u * i, row = c >> 5, ch = (c & 31u) * 4u;
        *(float4*)(sct + (size_t)row * 2048 + ch) = *(const float4*)&S[row][ch];
      }
    }
  }
}

__device__ __forceinline__ unsigned f2key(float f) {
  unsigned u = __float_as_uint(f);
  return (u & 0x80000000u) ? ~u : (u | 0x80000000u);
}
#define WAVE_LDS_SYNC() asm volatile("s_waitcnt lgkmcnt(0)" ::: "memory")
template <int NV>
__device__ __forceinline__ void wave_top16(const unsigned (&key)[NV], bool (&sel)[NV], int (&pos)[NV], int lane) {
  unsigned prefix = 0;
  int bit = 31;
  bool done = false;
  {
    int c0 = 0, c1 = 0, c2 = 0, c3 = 0, c4 = 0, c5 = 0;
#pragma unroll
    for (int m = 0; m < NV; m++) {
      c0 += __popcll(__ballot(key[m] >= 0xBF000000u));
      c1 += __popcll(__ballot(key[m] >= 0xBF800000u));
      c2 += __popcll(__ballot(key[m] >= 0xC0000000u));
      c3 += __popcll(__ballot(key[m] >= 0xC0800000u));
      c4 += __popcll(__ballot(key[m] >= 0xC1000000u));
      c5 += __popcll(__ballot(key[m] >= 0xC1800000u));
    }
    if (c0 >= 16 && c5 < 16) {
      unsigned pf = 0xBF000000u; int cp = c0;
      if (c1 >= 16) { pf = 0xBF800000u; cp = c1; }
      if (c2 >= 16) { pf = 0xC0000000u; cp = c2; }
      if (c3 >= 16) { pf = 0xC0800000u; cp = c3; }
      if (c4 >= 16) { pf = 0xC1000000u; cp = c4; }
      prefix = pf;
      bit = 22;
      done = (cp == 16);
    }
  }
  for (; bit >= 0 && !done; --bit) {
    unsigned T = prefix | (1u << bit);
    int cnt = 0;
#pragma unroll
    for (int m = 0; m < NV; m++) cnt += __popcll(__ballot(key[m] >= T));
    if (cnt >= 16) prefix = T;
    if (cnt == 16) break;
  }
  const unsigned long long lt = (1ull << lane) - 1ull;
  int ngt = 0;
#pragma unroll
  for (int m = 0; m < NV; m++) ngt += __popcll(__ballot(key[m] > prefix));
  const int need = 16 - ngt;
  int eqb = 0, selb = 0;
#pragma unroll
  for (int m = 0; m < NV; m++) {
    bool gt = key[m] > prefix, eq = key[m] == prefix;
    unsigned long long em = __ballot(eq);
    int er = eqb + __popcll(em & lt);
    bool s = gt || (eq && er < need);
    unsigned long long sm = __ballot(s);
    sel[m] = s;
    pos[m] = selb + __popcll(sm & lt);
    eqb += __popcll(em);
    selb += __popcll(sm);
  }
}

__device__ void peer_token(CParams& p, int tok, char* smem) {
  const int t = threadIdx.x, lane = t & 63, w = t >> 6;
  float* s_sc = (float*)smem;
  float* s_part = s_sc + 2048;
  float* s_red = s_part + 8192;
  float* s_sel_s = s_red + 64;
  int* s_sel_i = (int*)(s_sel_s + 128);
  float* s_ew = (float*)(s_sel_i + 128);
  int* s_ei = (int*)(s_ew + 128);
  const float* scores = (const float*)(p.ws + OFF_ZG) + (size_t)tok * 2048;
  float* yrow = p.out + O_Y + (size_t)tok * 2048;
  __syncthreads();
  float4 xa = *(const float4*)(yrow + t * 8), xb = *(const float4*)(yrow + t * 8 + 4);
  float ss = xa.x * xa.x + xa.y * xa.y + xa.z * xa.z + xa.w * xa.w + xb.x * xb.x + xb.y * xb.y + xb.z * xb.z + xb.w * xb.w;
  ss = wave_sum(ss);
  if (lane == 0) s_red[w] = ss;
  *(float4*)(s_sc + t * 4) = *(const float4*)(scores + t * 4);
  *(float4*)(s_sc + 1024 + t * 4) = *(const float4*)(scores + 1024 + t * 4);
  __syncthreads();
  const float rs = rsqrtf((s_red[0] + s_red[1] + s_red[2] + s_red[3]) * (1.f / 2048.f) + EPSF);
  float xn[32];
#pragma unroll
  for (int c = 0; c < 2; c++)
#pragma unroll
    for (int q4 = 0; q4 < 4; q4++) {
      float4 a = *(const float4*)(yrow + c * 1024 + lane * 16 + q4 * 4);
      float4 g = *(const float4*)(p.norm_ffn + c * 1024 + lane * 16 + q4 * 4);
      xn[c * 16 + q4 * 4 + 0] = a.x * rs * g.x; xn[c * 16 + q4 * 4 + 1] = a.y * rs * g.y;
      xn[c * 16 + q4 * 4 + 2] = a.z * rs * g.z; xn[c * 16 + q4 * 4 + 3] = a.w * rs * g.w;
    }
  for (int hh = 0; hh < 2; hh++) {
    const int h = 2 * w + hh;
#pragma unroll
    for (int pp = 0; pp < 2; pp++) {
      const int base = (h * 2 + pp) * 128;
      float v[2] = {s_sc[base + lane], s_sc[base + 64 + lane]};
      unsigned key[2] = {f2key(v[0]), f2key(v[1])};
      bool sel[2]; int pos[2];
      wave_top16<2>(key, sel, pos, lane);
#pragma unroll
      for (int m = 0; m < 2; m++)
        if (sel[m]) { s_sel_s[(w * 2 + pp) * 16 + pos[m]] = v[m]; s_sel_i[(w * 2 + pp) * 16 + pos[m]] = lane + 64 * m; }
    }
    WAVE_LDS_SYNC();
    {
      float s2v = s_sel_s[(w * 2 + 1) * 16 + (lane & 15)];
      float cand[4]; unsigned key[4]; bool sel[4]; int pos[4];
#pragma unroll
      for (int m = 0; m < 4; m++) { cand[m] = s_sel_s[(w * 2) * 16 + (lane >> 4) + 4 * m] + s2v; key[m] = f2key(cand[m]); }
      wave_top16<4>(key, sel, pos, lane);
#pragma unroll
      for (int m = 0; m < 4; m++)
        if (sel[m]) {
          s_ew[h * 16 + pos[m]] = cand[m];
          s_ei[h * 16 + pos[m]] = s_sel_i[(w * 2) * 16 + (lane >> 4) + 4 * m] * 128 + s_sel_i[(w * 2 + 1) * 16 + (lane & 15)];
        }
    }
    WAVE_LDS_SYNC();
    {
      float val = s_ew[h * 16 + (lane & 15)] * rs;
      float m = val;
      m = fmaxf(m, __shfl_xor(m, 1)); m = fmaxf(m, __shfl_xor(m, 2)); m = fmaxf(m, __shfl_xor(m, 4)); m = fmaxf(m, __shfl_xor(m, 8));
      float e = __expf(val - m);
      float sum = e;
      sum += __shfl_xor(sum, 1); sum += __shfl_xor(sum, 2); sum += __shfl_xor(sum, 4); sum += __shfl_xor(sum, 8);
      if (lane < 16) s_ew[h * 16 + lane] = e / sum;
    }
    WAVE_LDS_SYNC();
  }
  float acc[32];
#pragma unroll
  for (int j = 0; j < 32; j++) acc[j] = 0.f;
#define FP8_DOT(u4, xo, hacc) {                                                        \
    const unsigned d_[4] = {u4.x, u4.y, u4.z, u4.w};                                    \
    for (int q_ = 0; q_ < 4; q_++) {                                                    \
      auto lo_ = __builtin_amdgcn_cvt_pk_f32_fp8((int)d_[q_], false);                   \
      auto hi_ = __builtin_amdgcn_cvt_pk_f32_fp8((int)d_[q_], true);                    \
      hacc += lo_[0] * xn[(xo) + q_ * 4 + 0] + lo_[1] * xn[(xo) + q_ * 4 + 1] +         \
              hi_[0] * xn[(xo) + q_ * 4 + 2] + hi_[1] * xn[(xo) + q_ * 4 + 3];          \
    } }
#define FP8_AXPY(u4, xo, wgt) {                                                        \
    const unsigned d_[4] = {u4.x, u4.y, u4.z, u4.w};                                    \
    for (int q_ = 0; q_ < 4; q_++) {                                                    \
      auto lo_ = __builtin_amdgcn_cvt_pk_f32_fp8((int)d_[q_], false);                   \
      auto hi_ = __builtin_amdgcn_cvt_pk_f32_fp8((int)d_[q_], true);                    \
      acc[(xo) + q_ * 4 + 0] += wgt * lo_[0]; acc[(xo) + q_ * 4 + 1] += wgt * lo_[1];   \
      acc[(xo) + q_ * 4 + 2] += wgt * hi_[0]; acc[(xo) + q_ * 4 + 3] += wgt * hi_[1];   \
    } }
  const unsigned char* U8 = (const unsigned char*)(p.ws + OFF_U);
  const unsigned char* V8 = (const unsigned char*)(p.ws + OFF_V);
  uint4 ru[4][2], rv[4][2];
  float g[4];
  {
#pragma unroll
    for (int u = 0; u < 4; u++) {
      const int e = s_ei[w * 32 + u];
      g[u] = s_ew[w * 32 + u];
      const uint4* up = (const uint4*)(U8 + (size_t)e * 2048) + lane;
      ru[u][0] = up[0]; ru[u][1] = up[64];
    }
#pragma unroll
    for (int u = 0; u < 4; u++) {
      const int e = s_ei[w * 32 + u];
      const uint4* vp = (const uint4*)(V8 + (size_t)e * 2048) + lane;
      rv[u][0] = vp[0]; rv[u][1] = vp[64];
    }
  }
#pragma unroll 1
  for (int q = 0; q < 32; q += 4) {
    float hh[4];
#pragma unroll
    for (int u = 0; u < 4; u++) {
      float ha = 0.f;
#pragma unroll
      for (int c = 0; c < 2; c++) FP8_DOT(ru[u][c], c * 16, ha)
      hh[u] = ha;
    }
    const int qn = (q + 4 < 32) ? q + 4 : q;
    float gn[4];
#pragma unroll
    for (int u = 0; u < 4; u++) {
      const int e = s_ei[w * 32 + qn + u];
      gn[u] = s_ew[w * 32 + qn + u];
      const uint4* up = (const uint4*)(U8 + (size_t)e * 2048) + lane;
      ru[u][0] = up[0]; ru[u][1] = up[64];
    }
#pragma unroll
    for (int o = 32; o; o >>= 1) {
#pragma unroll
      for (int u = 0; u < 4; u++) hh[u] += __shfl_xor(hh[u], o);
    }
#pragma unroll
    for (int u = 0; u < 4; u++) {
      const float wg = gelu_tanh(hh[u] * (1.f / 1024.f)) * g[u] * (1.f / 256.f);
#pragma unroll
      for (int c = 0; c < 2; c++) FP8_AXPY(rv[u][c], c * 16, wg)
    }
#pragma unroll
    for (int u = 0; u < 4; u++) {
      const int e = s_ei[w * 32 + qn + u];
      const uint4* vp = (const uint4*)(V8 + (size_t)e * 2048) + lane;
      rv[u][0] = vp[0]; rv[u][1] = vp[64];
      g[u] = gn[u];
    }
  }
#pragma unroll
  for (int c = 0; c < 2; c++) {
    float* d = s_part + w * 2048 + c * 1024 + lane * 16;
#pragma unroll
    for (int q4 = 0; q4 < 4; q4++)
      *(float4*)(d + q4 * 4) = make_float4(acc[c * 16 + q4 * 4 + 0], acc[c * 16 + q4 * 4 + 1], acc[c * 16 + q4 * 4 + 2], acc[c * 16 + q4 * 4 + 3]);
  }
  __syncthreads();
  float x2[8] = {xa.x, xa.y, xa.z, xa.w, xb.x, xb.y, xb.z, xb.w};
#pragma unroll
  for (int ww = 0; ww < 4; ww++) {
    float4 a = *(const float4*)(s_part + ww * 2048 + t * 8), b = *(const float4*)(s_part + ww * 2048 + t * 8 + 4);
    x2[0] += a.x; x2[1] += a.y; x2[2] += a.z; x2[3] += a.w; x2[4] += b.x; x2[5] += b.y; x2[6] += b.z; x2[7] += b.w;
  }
  *(float4*)(yrow + t * 8) = make_float4(x2[0], x2[1], x2[2], x2[3]);
  *(float4*)(yrow + t * 8 + 4) = make_float4(x2[4], x2[5], x2[6], x2[7]);
  float ss2 = 0.f;
#pragma unroll
  for (int j = 0; j < 8; j++) ss2 += x2[j] * x2[j];
  ss2 = wave_sum(ss2);
  if (lane == 0) s_red[8 + w] = ss2;
  __syncthreads();
  const float rs2 = rsqrtf((s_red[8] + s_red[9] + s_red[10] + s_red[11]) * (1.f / 2048.f) + EPSF);
  {
    const float* g = p.norm_ple + t * 8;
    float f[8];
#pragma unroll
    for (int j = 0; j < 8; j++) f[j] = x2[j] * rs2 * g[j];
    *(uint4*)((bf16_t*)(p.ws + OFF_ZR) + (size_t)tok * 2048 + t * 8) = pack8(f);
    ((bf16_t*)(p.ws + OFF_PLB))[(size_t)tok * 256 + t] = f2bf(ple_row(p, tok)[t]);
  }
}
__device__ void phase_peer(CParams& p, char* smem) {
  for (int tok = blockIdx.x; tok < NTOK; tok += gridDim.x) peer_token(p, tok, smem);
}

__device__ void phase_ple(CParams& p, char* smem) {
  EPI_VARS
  const bf16_t* plb = (const bf16_t*)(p.ws + OFF_PLB);
  const bf16_t* x2n = (const bf16_t*)(p.ws + OFF_ZR);
  const bf16_t* wsw = (const bf16_t*)(p.ws + OFF_W);
  const int x = blockIdx.x & 7, per = gridDim.x >> 3;
  if ((int)blockIdx.x >= per * 8) return;
  for (int q = blockIdx.x >> 3;; q += per) {
    int mt, nt;
    if (!tile_at(q, x, 1, 16, 88, 1, mt, nt)) break;
    f32x4 acc[4][6];
    zero_acc6(acc);
    gemm_loop3(acc, plb + (size_t)mt * 192 * 256, 256, wsw + W_PLE + (size_t)nt * 128 * 256, 256, 256, smem);
    {
    uint4* tmp = (uint4*)(p.ws + OFF_ZG) + ((size_t)(mt * 16 + nt) * 12) * 256 + opaque_u(threadIdx.x);
#pragma unroll
    for (int mm = 0; mm < 6; mm++)
#pragma unroll
      for (int n2 = 0; n2 < 2; n2++) {
        uint4 o;
        o.x = pack2(acc[2 * n2][mm][0], acc[2 * n2][mm][1]);
        o.y = pack2(acc[2 * n2][mm][2], acc[2 * n2][mm][3]);
        o.z = pack2(acc[2 * n2 + 1][mm][0], acc[2 * n2 + 1][mm][1]);
        o.w = pack2(acc[2 * n2 + 1][mm][2], acc[2 * n2 + 1][mm][3]);
        tmp[(mm * 2 + n2) * 256] = o;
      }
    }
    zero_acc6(acc);
    gemm_loop3(acc, x2n + (size_t)mt * 192 * 2048, 2048, wsw + W_GATE + (size_t)nt * 128 * 2048, 2048, 2048, smem);
    asm volatile("" ::: "memory");
    float* yt = p.out + O_Y + (size_t)mt * 192 * 2048 + nt * 128;
    const uint4* tmp = (const uint4*)(p.ws + OFF_ZG) + ((size_t)(mt * 16 + nt) * 12) * 256 + opaque_u(threadIdx.x);
    const unsigned lo = opaque_u(LROW3 * 2048 + LCOL8);
#pragma unroll
    for (int mm = 0; mm < 6; mm++)
#pragma unroll
      for (int n2 = 0; n2 < 2; n2++) {
        const uint4 a1 = tmp[(mm * 2 + n2) * 256];
#pragma unroll
        for (int h2 = 0; h2 < 2; h2++) {
          const int nn = 2 * n2 + h2;
          const unsigned alo = h2 ? a1.z : a1.x, ahi = h2 ? a1.w : a1.y;
          float4* yp = (float4*)(yt + lo + (unsigned)(mm * 16 * 2048 + n2 * 32 + h2 * 4));
          float4 y = *yp;
          y.x += lo2f(alo) * sigmoidf_(acc[nn][mm][0]);
          y.y += hi2f(alo) * sigmoidf_(acc[nn][mm][1]);
          y.z += lo2f(ahi) * sigmoidf_(acc[nn][mm][2]);
          y.w += hi2f(ahi) * sigmoidf_(acc[nn][mm][3]);
          *yp = y;
        }
      }
  }
}

#define XB_TMO      128
#define XB_XCNT(j)  (256  + 64 * (j))
#define XB_XSUB(j)  (1280 + 64 * (j))
#define XB_XGEN(j)  (2304 + 64 * (j))
#define XB_TOP      3328
#define XB_TOPGEN   3392
#define XB_SPIN_CAP (1u << 22)
__device__ __forceinline__ unsigned xb_ld(unsigned* p) { return __hip_atomic_load(p, __ATOMIC_RELAXED, __HIP_MEMORY_SCOPE_AGENT); }
__device__ __forceinline__ unsigned xb_add(unsigned* p, unsigned v) { return __hip_atomic_fetch_add(p, v, __ATOMIC_RELAXED, __HIP_MEMORY_SCOPE_AGENT); }
__device__ __forceinline__ unsigned xb_xcc_id() { return (unsigned)__builtin_amdgcn_s_getreg((3 << 11) | 20) & 0xFu; }
#define XB_SPIN(cond, bar) do { unsigned _sp = 0; while (cond) { __builtin_amdgcn_s_sleep(1); \
    if ((++_sp & 255u) == 0u) { if (xb_ld(&(bar)[XB_TMO])) break; if (_sp > XB_SPIN_CAP) { atomicAdd(&(bar)[XB_TMO], 1u); break; } } } } while (0)

__device__ __forceinline__ void xcd_barrier_post(unsigned* bar) {
  if (threadIdx.x == 0) (void)xb_add(&bar[XB_XCNT(xb_xcc_id())], 1u);
}
__device__ __noinline__ void xcd_sync(unsigned* bar) {
  asm volatile("s_waitcnt vmcnt(0)" ::: "memory");
  __syncthreads();
  if (threadIdx.x == 0) {
    __builtin_amdgcn_s_waitcnt(0);
    const unsigned x = xb_xcc_id();
    unsigned packed = bar[3456 + blockIdx.x];
    unsigned nloc = packed & 0xffffu, nx = packed >> 16;
    if (nloc == 0u) {
      const unsigned G = gridDim.x;
      unsigned sum, cnt, mine, sp = 0u;
      for (;;) {
        sum = 0u; cnt = 0u; mine = 0u;
#pragma unroll
        for (unsigned j = 0; j < 16; ++j) { const unsigned c = xb_ld(&bar[XB_XCNT(j)]); sum += c; cnt += (c > 0u) ? 1u : 0u; mine = (j == x) ? c : mine; }
        if (sum == G) break;
        __builtin_amdgcn_s_sleep(1);
        if ((++sp & 255u) == 0u) { if (xb_ld(&bar[XB_TMO])) break; if (sp > XB_SPIN_CAP) { atomicAdd(&bar[XB_TMO], 1u); break; } }
      }
      nloc = mine > 0u ? mine : 1u; nx = cnt > 0u ? cnt : 1u;
      bar[3456 + blockIdx.x] = nloc | (nx << 16);
    }
    const unsigned old = xb_add(&bar[XB_XSUB(x)], 1u);
    const unsigned gen = old / nloc;
    if (old + 1u == (gen + 1u) * nloc) {
      __builtin_amdgcn_fence(__ATOMIC_RELEASE, "agent");
      asm volatile("s_waitcnt vmcnt(0)" ::: "memory");
      const unsigned og = xb_add(&bar[XB_TOP], 1u);
      const unsigned tg = og / nx;
      if (og + 1u == (tg + 1u) * nx) xb_add(&bar[XB_TOPGEN], 1u);
      else XB_SPIN(xb_ld(&bar[XB_TOPGEN]) == tg, bar);
      __builtin_amdgcn_fence(__ATOMIC_ACQUIRE, "agent");
      xb_add(&bar[XB_XGEN(x)], 1u);
      asm volatile("s_waitcnt vmcnt(0)" ::: "memory");
    } else {
      XB_SPIN(xb_ld(&bar[XB_XGEN(x)]) == gen, bar);
      __builtin_amdgcn_fence(__ATOMIC_ACQUIRE, "agent");
      asm volatile("s_waitcnt vmcnt(0)" ::: "memory");
    }
  }
  __syncthreads();
}

__global__ void __launch_bounds__(256, 2) mega_kernel(Params p_unused) {
  __shared__ __attribute__((aligned(16))) char smem[81920];
  xcd_barrier_post((unsigned*)(get_params()->ws + OFF_BAR));
  { CParams& p = *get_params(); phase_prep(p, smem); }
  xcd_sync((unsigned*)(get_params()->ws + OFF_BAR));
  { CParams& p = *get_params(); phase_gemm1(p, smem); }
  xcd_sync((unsigned*)(get_params()->ws + OFF_BAR));
  { CParams& p = *get_params(); phase_mix(p, smem); }
  xcd_sync((unsigned*)(get_params()->ws + OFF_BAR));
  { CParams& p = *get_params(); phase_scan2(p); }
  xcd_sync((unsigned*)(get_params()->ws + OFF_BAR));
  { CParams& p = *get_params(); phase_proj(p, smem); }
  xcd_sync((unsigned*)(get_params()->ws + OFF_BAR));
  { CParams& p = *get_params(); phase_wout(p, smem); }
  xcd_sync((unsigned*)(get_params()->ws + OFF_BAR));
  { CParams& p = *get_params(); phase_pq(p, smem); }
  xcd_sync((unsigned*)(get_params()->ws + OFF_BAR));
  { CParams& p = *get_params(); phase_peer(p, smem); }
  xcd_sync((unsigned*)(get_params()->ws + OFF_BAR));
  { CParams& p = *get_params(); phase_ple(p, smem); }
  if (get_params()->ws == nullptr) cg::this_grid().sync();
}

extern "C" void kernel_launch(void* const* d_in, const int* in_sizes, int n_in, void* d_out, int out_size, void* d_ws,
                              size_t ws_size, hipStream_t stream) {
  static int grid_blocks = 0;
  if (!grid_blocks) {
    int dev = 0, cus = 0, per_cu = 0;
    hipGetDevice(&dev);
    hipDeviceGetAttribute(&cus, hipDeviceAttributeMultiprocessorCount, dev);
    hipOccupancyMaxActiveBlocksPerMultiprocessor(&per_cu, mega_kernel, 256, 0);
    if (per_cu > 2) per_cu = 2;
    grid_blocks = cus * per_cu;
    if (ws_size < WS_NEED) fprintf(stderr, "workspace too small: %zu < %zu\n", ws_size, (size_t)WS_NEED);
  }
  Params p{};
  const float** pp = (const float**)&p;
  for (int i = 0; i < 31; i++) pp[i] = (const float*)d_in[i];
  p.out = (float*)d_out;
  p.ws = (char*)d_ws;
  hipMemsetAsync((char*)d_ws + OFF_BAR, 0, 16384, stream);
  void* args[] = {&p};
  hipError_t e = hipLaunchCooperativeKernel((void*)mega_kernel, dim3(grid_blocks), dim3(256), args, 0, stream);
  if (e != hipSuccess) fprintf(stderr, "cooperative launch failed: %s (grid %d)\n", hipGetErrorString(e), grid_blocks);
}
```

```cpp
#include <hip/hip_runtime.h>
#include <hip/hip_cooperative_groups.h>
#include <stdint.h>
#include <cstdio>
namespace cg = cooperative_groups;

#ifndef MEGA
#define MEGA 1
#endif

typedef unsigned short bf16_t;
using bf16x8 = __attribute__((ext_vector_type(8))) short;
using f32x16 = __attribute__((ext_vector_type(16))) float;
using u32x8 = __attribute__((ext_vector_type(8))) unsigned;
using u32x2 = __attribute__((ext_vector_type(2))) unsigned;

#define NTOK 16896
#define NPROMPT 16384
#define EPSF 1e-6f

#define OFF_R1   ((size_t)0)
#define OFF_ZR   (OFF_R1 + (size_t)69206016)
#define OFF_ZG   (OFF_ZR + (size_t)121110528)
#define OFF_W    (OFF_ZG + (size_t)138412032)
#define OFF_U    (OFF_W + (size_t)67108864)
#define OFF_V    (OFF_U + (size_t)33554432)
#define OFF_SUM  (OFF_V + (size_t)33554432)
#define OFF_ROPE (OFF_SUM + (size_t)4194304)
#define OFF_PLB  (OFF_ROPE + (size_t)262400)
#define OFF_BAR  (OFF_PLB + (size_t)8650752)
#define WS_NEED  (OFF_BAR + (size_t)16384)

#define W_IN   ((size_t)0)
#define W_RNN  (W_IN + (size_t)7680 * 2048)
#define W_ATT  (W_RNN + (size_t)2048 * 1024)
#define W_OUT  (W_ATT + (size_t)2048 * 1024)
#define W_PQ   (W_OUT + (size_t)2048 * 2048)
#define W_PLE  (W_PQ + (size_t)2048 * 2048)
#define W_GATE (W_PLE + (size_t)2048 * 256)
#define W_RG   (W_GATE + (size_t)2048 * 2048)
#define W_IG   (W_RG + (size_t)8 * 128 * 128)
#define W_SK   (W_IG + (size_t)8 * 128 * 128)

#define O_Y      ((size_t)0)
#define O_PCONV  ((size_t)34603008)
#define O_PRG    ((size_t)34615296)
#define O_PK     ((size_t)34619392)
#define O_PV     ((size_t)34750464)
#define O_SCONV  ((size_t)34881536)
#define O_SRG    ((size_t)35274752)
#define O_SK     ((size_t)35405824)
#define O_SV     ((size_t)39600128)

struct Params {
  const float *x_prompt, *x_sample, *p_prompt, *p_sample, *state_conv, *state_rglru, *cache_k, *cache_v;
  const float *norm_mix, *w_in, *conv_w, *conv_b, *w_rgate, *b_rgate, *w_igate, *b_igate, *lru_lambda, *w_proj_rnn;
  const float *q_norm, *k_norm, *attn_sinks, *w_proj_attn, *w_out, *norm_ffn, *w_peer_q, *sub_keys, *peer_u, *peer_v;
  const float *w_ple, *norm_ple, *w_ple_gate;
  float* out;
  char* ws;
};

typedef const __attribute__((address_space(4))) Params CParams;
__device__ __forceinline__ CParams* get_params() {
  CParams* kp = (CParams*)__builtin_amdgcn_kernarg_segment_ptr();
  asm volatile("" : "+s"(kp));
  return kp;
}
__device__ __forceinline__ bf16_t f2bf(float f) {
  unsigned u = __float_as_uint(f);
  u += 0x7fffu + ((u >> 16) & 1u);
  return (bf16_t)(u >> 16);
}
__device__ __forceinline__ float bf2f(bf16_t b) { return __uint_as_float(((unsigned)b) << 16); }
__device__ __forceinline__ unsigned pack2(float a, float b) { return (unsigned)f2bf(a) | ((unsigned)f2bf(b) << 16); }
__device__ __forceinline__ float lo2f(unsigned d) { return __uint_as_float(d << 16); }
__device__ __forceinline__ float hi2f(unsigned d) { return __uint_as_float(d & 0xffff0000u); }
__device__ __forceinline__ float sigmoidf_(float x) { return __builtin_amdgcn_rcpf(1.f + __expf(-x)); }
__device__ __forceinline__ float gelu_tanh(float x) {
  float y = 0.7978845608028654f * (x + 0.044715f * x * x * x);
  float th = 1.f - 2.f * __builtin_amdgcn_rcpf(1.f + __expf(2.f * y));
  return 0.5f * x * (1.f + th);
}
__device__ __forceinline__ float wave_sum(float v) {
#pragma unroll
  for (int o = 32; o; o >>= 1) v += __shfl_xor(v, o);
  return v;
}
__device__ __forceinline__ float wave_max(float v) {
#pragma unroll
  for (int o = 32; o; o >>= 1) v = fmaxf(v, __shfl_xor(v, o));
  return v;
}
__device__ __forceinline__ void unpack8(const uint4& u, float* f) {
  f[0] = lo2f(u.x); f[1] = hi2f(u.x); f[2] = lo2f(u.y); f[3] = hi2f(u.y);
  f[4] = lo2f(u.z); f[5] = hi2f(u.z); f[6] = lo2f(u.w); f[7] = hi2f(u.w);
}
__device__ __forceinline__ uint4 pack8(const float* f) {
  uint4 u; u.x = pack2(f[0], f[1]); u.y = pack2(f[2], f[3]); u.z = pack2(f[4], f[5]); u.w = pack2(f[6], f[7]);
  return u;
}
__device__ __forceinline__ const float* x_row(CParams& p, int tok) {
  return tok < NPROMPT ? p.x_prompt + (size_t)tok * 2048 : p.x_sample + (size_t)(tok - NPROMPT) * 2048;
}
__device__ __forceinline__ const float* ple_row(CParams& p, int tok) {
  return tok < NPROMPT ? p.p_prompt + (size_t)tok * 256 : p.p_sample + (size_t)(tok - NPROMPT) * 256;
}

__device__ __forceinline__ bool tile_at(int q, int x, int SM, int SN, int NSM, int NSN, int& mt, int& nt) {
  int ST = SM * SN;
  int sup = (q / ST) * 8 + x;
  if (sup >= NSM * NSN) return false;
  int wi = q % ST;
  mt = (sup / NSN) * SM + wi / SN;
  nt = (sup % NSN) * SN + wi % SN;
  return true;
}

using f32x4 = __attribute__((ext_vector_type(4))) float;
__device__ __forceinline__ void stage_rc(int b, int& R, int& C) {
  int st = b >> 10, sb = b & 1023, swz = sb ^ (((sb >> 9) & 1) << 5);
  R = (st >> 1) * 16 + (swz >> 6);
  C = (st & 1) * 32 + ((swz & 63) >> 1);
}
__device__ __forceinline__ void gemm_loop(f32x4 (&acc)[4][4], const bf16_t* __restrict__ A, int lda,
                                          const bf16_t* __restrict__ B, int ldb, int K, char* smem) {
  const int t = threadIdx.x, lane = t & 63, w = t >> 6, wm = w >> 1, wn = w & 1;
  const int fr = lane & 15, fq = lane >> 4;
  unsigned aoff[4], boff[4];
#pragma unroll
  for (int i = 0; i < 4; i++) {
    int R, C;
    stage_rc(t * 16 + i * 4096, R, C);
    aoff[i] = R * lda + C;
    boff[i] = R * ldb + C;
  }
#define GL_STAGE(s, ko)                                                                                             \
  _Pragma("unroll") for (int i_ = 0; i_ < 4; i_++) {                                                                \
    __builtin_amdgcn_global_load_lds((const unsigned*)(A + aoff[i_] + (ko)),                                        \
                                     (unsigned*)(smem + (s) * 32768 + t * 16 + i_ * 4096), 16, 0, 0);               \
    __builtin_amdgcn_global_load_lds((const unsigned*)(B + boff[i_] + (ko)),                                        \
                                     (unsigned*)(smem + (s) * 32768 + 16384 + t * 16 + i_ * 4096), 16, 0, 0);       \
  }
  const int lane_off = ((fr * 64 + fq * 16) ^ ((fr >> 3) << 5));
  const int a_base = wm * 8192 + lane_off, b_base = 16384 + wn * 8192 + lane_off;
  __syncthreads();
  GL_STAGE(0, 0)
  const int nt = K >> 6;
  for (int kt = 0; kt < nt; kt++) {
    const int cur = kt & 1;
    __syncthreads();
    if (kt + 1 < nt) { GL_STAGE(cur ^ 1, (kt + 1) * 64) }
    const char* sb = smem + cur * 32768;
#pragma unroll
    for (int k2 = 0; k2 < 2; k2++) {
      bf16x8 af[4], bfr[4];
#pragma unroll
      for (int m = 0; m < 4; m++) af[m] = *(const bf16x8*)(sb + a_base + m * 2048 + k2 * 1024);
#pragma unroll
      for (int n = 0; n < 4; n++) bfr[n] = *(const bf16x8*)(sb + b_base + n * 2048 + k2 * 1024);
#pragma unroll
      for (int n = 0; n < 4; n++)
#pragma unroll
        for (int m = 0; m < 4; m++) acc[n][m] = __builtin_amdgcn_mfma_f32_16x16x32_bf16(bfr[n], af[m], acc[n][m], 0, 0, 0);
    }
  }
}
__device__ __forceinline__ void zero_acc4(f32x4 (&acc)[4][4]) {
#pragma unroll
  for (int i = 0; i < 4; i++)
#pragma unroll
    for (int j = 0; j < 4; j++) acc[i][j] = (f32x4){0.f, 0.f, 0.f, 0.f};
}
#define LROW2 (wm * 64 + (lane & 15))
#define LCOL2 (wn * 64 + (lane >> 4) * 4)

#define G3_STAGE_BYTES 40960
#define G3_B_OFF 24576
__device__ __forceinline__ void gemm_loop3(f32x4 (&acc)[4][6], const bf16_t* __restrict__ A, int lda,
                                           const bf16_t* __restrict__ B, int ldb, int K, char* smem) {
  const int t = threadIdx.x, lane = t & 63, w = t >> 6, wm = w >> 1, wn = w & 1;
  const int fr = lane & 15, fq = lane >> 4;
  unsigned aoff[6], boff[4];
#pragma unroll
  for (int i = 0; i < 6; i++) {
    int R, C;
    stage_rc(t * 16 + i * 4096, R, C);
    aoff[i] = R * lda + C;
    if (i < 4) boff[i] = R * ldb + C;
  }
#define G3_ISSUE(s, ko)                                                                                        \
  {                                                                                                            \
    char* sb_ = smem + (s) * G3_STAGE_BYTES + t * 16;                                                          \
    _Pragma("unroll") for (int i_ = 0; i_ < 6; i_++)                                                           \
        __builtin_amdgcn_global_load_lds((const unsigned*)(A + (unsigned)(aoff[i_] + (ko))), (unsigned*)(sb_ + i_ * 4096), 16, 0, 0); \
    _Pragma("unroll") for (int i_ = 0; i_ < 4; i_++)                                                           \
        __builtin_amdgcn_global_load_lds((const unsigned*)(B + (unsigned)(boff[i_] + (ko))), (unsigned*)(sb_ + G3_B_OFF + i_ * 4096), 16, 0, 0); \
  }
  const int lane_off = ((fr * 64 + fq * 16) ^ ((fr >> 3) << 5));
  const int a_base = wm * 12288 + lane_off, b_base = G3_B_OFF + wn * 8192 + lane_off;
  __syncthreads();
  const int nt = K >> 6;
  G3_ISSUE(0, 0)
  for (int kt = 0; kt < nt; kt++) {
    const int cur = kt & 1;
    __syncthreads();
    if (kt + 1 < nt) G3_ISSUE(cur ^ 1, (kt + 1) * 64)
    const char* sb = smem + cur * G3_STAGE_BYTES;
#pragma unroll
    for (int k2 = 0; k2 < 2; k2++) {
      bf16x8 af[6], bfr[4];
#pragma unroll
      for (int m = 0; m < 6; m++) af[m] = *(const bf16x8*)(sb + a_base + m * 2048 + k2 * 1024);
#pragma unroll
      for (int n = 0; n < 4; n++) bfr[n] = *(const bf16x8*)(sb + b_base + n * 2048 + k2 * 1024);
#pragma unroll
      for (int n = 0; n < 4; n++)
#pragma unroll
        for (int m = 0; m < 6; m++) acc[n][m] = __builtin_amdgcn_mfma_f32_16x16x32_bf16(bfr[n], af[m], acc[n][m], 0, 0, 0);
      __builtin_amdgcn_sched_barrier(0);
    }
  }
}
__device__ __forceinline__ void zero_acc6(f32x4 (&acc)[4][6]) {
#pragma unroll
  for (int i = 0; i < 4; i++)
#pragma unroll
    for (int j = 0; j < 6; j++) acc[i][j] = (f32x4){0.f, 0.f, 0.f, 0.f};
}
#define LROW3 (wm * 96 + (lane & 15))

__device__ __forceinline__ void lds_gemm128(f32x16 (&acc)[2][2], const bf16_t (*A2)[136], const bf16_t (*B2)[136]) {
  const int t = threadIdx.x, lane = t & 63, w = t >> 6, wm = w >> 1, wn = w & 1;
  const int fr = lane & 31, fk = (lane >> 5) * 8;
#pragma unroll
  for (int kk = 0; kk < 8; kk++) {
    bf16x8 a0 = *(const bf16x8*)&A2[wm * 64 + fr][kk * 16 + fk];
    bf16x8 a1 = *(const bf16x8*)&A2[wm * 64 + 32 + fr][kk * 16 + fk];
    bf16x8 b0 = *(const bf16x8*)&B2[wn * 64 + fr][kk * 16 + fk];
    bf16x8 b1 = *(const bf16x8*)&B2[wn * 64 + 32 + fr][kk * 16 + fk];
    acc[0][0] = __builtin_amdgcn_mfma_f32_32x32x16_bf16(a0, b0, acc[0][0], 0, 0, 0);
    acc[0][1] = __builtin_amdgcn_mfma_f32_32x32x16_bf16(a0, b1, acc[0][1], 0, 0, 0);
    acc[1][0] = __builtin_amdgcn_mfma_f32_32x32x16_bf16(a1, b0, acc[1][0], 0, 0, 0);
    acc[1][1] = __builtin_amdgcn_mfma_f32_32x32x16_bf16(a1, b1, acc[1][1], 0, 0, 0);
  }
}
__device__ __forceinline__ void load_b2(bf16_t (*B2)[136], const bf16_t* __restrict__ src) {
  const int t = threadIdx.x;
#pragma unroll
  for (int i = 0; i < 8; i++) {
    int c = t + 256 * i, row = c >> 4, col = (c & 15) * 8;
    *(uint4*)&B2[row][col] = *(const uint4*)(src + row * 128 + col);
  }
}
__device__ __forceinline__ void zero_acc(f32x16 (&acc)[2][2]) {
#pragma unroll
  for (int i = 0; i < 2; i++)
#pragma unroll
    for (int j = 0; j < 2; j++)
#pragma unroll
      for (int r = 0; r < 16; r++) acc[i][j][r] = 0.f;
}
#define ACC_ROW(i, r) (wm * 64 + (i) * 32 + ((r) & 3) + 8 * ((r) >> 2) + 4 * (lane >> 5))
#define ACC_COL(j) (wn * 64 + (j) * 32 + (lane & 31))
#define EPI_VARS const int lane = threadIdx.x & 63, wm = threadIdx.x >> 7, wn = (threadIdx.x >> 6) & 1;
#define ROWC(i, r) ((i) * 32 + ((r) & 3) + 8 * ((r) >> 2))
#define LROW (wm * 64 + 4 * (lane >> 5))
#define LCOL (wn * 64 + (lane & 31))
__device__ __forceinline__ unsigned opaque_u(unsigned v) { asm volatile("" : "+v"(v)); return v; }

typedef float nt_f4 __attribute__((ext_vector_type(4)));
__device__ __forceinline__ float4 ld_nt4(const float* p) { nt_f4 v = __builtin_nontemporal_load((const nt_f4*)p); return make_float4(v.x, v.y, v.z, v.w); }
__device__ void transpose_tile(const float* __restrict__ src, int ld_src, bf16_t* __restrict__ dst, int ld_dst,
                               int k0, int n0, const float* __restrict__ kscale, char* smem) {
  float (*tile)[65] = (float (*)[65])smem;
  const int t = threadIdx.x;
  __syncthreads();
  const int n4 = (t & 15) * 4, kr = t >> 4;
#pragma unroll
  for (int i = 0; i < 4; i++) {
    int k = kr + 16 * i;
    float4 v = ld_nt4(src + (size_t)(k0 + k) * ld_src + n0 + n4);
    float s = kscale ? kscale[k0 + k] : 1.f;
    tile[k][n4 + 0] = v.x * s; tile[k][n4 + 1] = v.y * s; tile[k][n4 + 2] = v.z * s; tile[k][n4 + 3] = v.w * s;
  }
  __syncthreads();
  const int n = t >> 2, ks = (t & 3) * 16;
  float f[16];
#pragma unroll
  for (int j = 0; j < 16; j++) f[j] = tile[ks + j][n];
  uint4* d = (uint4*)(dst + (size_t)(n0 + n) * ld_dst + k0 + ks);
  d[0] = pack8(f); d[1] = pack8(f + 8);
}

__device__ void phase_prep(CParams& p, char* smem) {
  const int t = threadIdx.x, lane = t & 63, w = t >> 6;
  bf16_t* wsw = (bf16_t*)(p.ws + OFF_W);
  const int N_RMS = NTOK / 4, N_TR = 8128, N_SK = 128, N_UV = 32768, N_ROPE = 129;
  const int TOTAL = N_RMS + N_TR + N_SK + N_UV + N_ROPE;
  for (int it = blockIdx.x; it < TOTAL; it += gridDim.x) {
    int i = it;
    if (i < N_UV) {
      const bool isu = i < 16384;
      const float* src = isu ? p.peer_u + (size_t)i * 2048 : p.peer_v + (size_t)(i - 16384) * 2048;
      unsigned char* dst = (unsigned char*)(p.ws + (isu ? OFF_U : OFF_V)) + (size_t)(i & 16383) * 2048;
      const float sc = isu ? 1024.f : 256.f;
      float4 a = ld_nt4(src + t * 8), b = ld_nt4(src + t * 8 + 4);
      int w0 = __builtin_amdgcn_cvt_pk_fp8_f32(a.x * sc, a.y * sc, 0, false);
      w0 = __builtin_amdgcn_cvt_pk_fp8_f32(a.z * sc, a.w * sc, w0, true);
      int w1 = __builtin_amdgcn_cvt_pk_fp8_f32(b.x * sc, b.y * sc, 0, false);
      w1 = __builtin_amdgcn_cvt_pk_fp8_f32(b.z * sc, b.w * sc, w1, true);
      *(uint2*)(dst + t * 8) = make_uint2((unsigned)w0, (unsigned)w1);
      continue;
    }
    i -= N_UV;
    if (i < N_RMS) {
      int tok = i * 4 + w;
      const float* xr = x_row(p, tok);
      float v[32]; float ss = 0.f;
#pragma unroll
      for (int c = 0; c < 4; c++) {
        float4 a = ld_nt4(xr + c * 512 + lane * 8), b = ld_nt4(xr + c * 512 + lane * 8 + 4);
        v[c * 8 + 0] = a.x; v[c * 8 + 1] = a.y; v[c * 8 + 2] = a.z; v[c * 8 + 3] = a.w;
        v[c * 8 + 4] = b.x; v[c * 8 + 5] = b.y; v[c * 8 + 6] = b.z; v[c * 8 + 7] = b.w;
      }
#pragma unroll
      for (int j = 0; j < 32; j++) ss += v[j] * v[j];
      ss = wave_sum(ss);
      float rs = rsqrtf(ss * (1.f / 2048.f) + EPSF);
      bf16_t* dst = (bf16_t*)(p.ws + OFF_R1) + (size_t)tok * 2048;
#pragma unroll
      for (int c = 0; c < 4; c++) {
        const float* g = p.norm_mix + c * 512 + lane * 8;
        float f[8];
#pragma unroll
        for (int j = 0; j < 8; j++) f[j] = v[c * 8 + j] * rs * g[j];
        *(uint4*)(dst + c * 512 + lane * 8) = pack8(f);
      }
      continue;
    }
    i -= N_RMS;
    if (i < N_TR) {
      const float* src; bf16_t* dst; int K, Nn; const float* ks = nullptr;
      if (i < 3840) { src = p.w_in; dst = wsw + W_IN; K = 2048; Nn = 7680; }
      else if ((i -= 3840) < 512) { src = p.w_proj_rnn; dst = wsw + W_RNN; K = 1024; Nn = 2048; }
      else if ((i -= 512) < 512) { src = p.w_proj_attn; dst = wsw + W_ATT; K = 1024; Nn = 2048; }
      else if ((i -= 512) < 1024) { src = p.w_out; dst = wsw + W_OUT; K = 2048; Nn = 2048; }
      else if ((i -= 1024) < 1024) { src = p.w_peer_q; dst = wsw + W_PQ; K = 2048; Nn = 2048; ks = p.norm_ffn; }
      else if ((i -= 1024) < 128) { src = p.w_ple; dst = wsw + W_PLE; K = 256; Nn = 2048; }
      else if ((i -= 128) < 1024) { src = p.w_ple_gate; dst = wsw + W_GATE; K = 2048; Nn = 2048; }
      else if ((i -= 1024) < 32) { int b = i >> 2; src = p.w_rgate + b * 16384; dst = wsw + W_RG + b * 16384; K = 128; Nn = 128; i &= 3; }
      else { i -= 32; int b = i >> 2; src = p.w_igate + b * 16384; dst = wsw + W_IG + b * 16384; K = 128; Nn = 128; i &= 3; }
      int nkt = K / 64;
      int kt = i % nkt, ntile = i / nkt;
      transpose_tile(src, Nn, dst, K, kt * 64, ntile * 64, ks, smem);
      continue;
    }
    i -= N_TR;
    if (i < N_SK) {
      const float* src = p.sub_keys + (size_t)i * 2048;
      bf16_t* dst = wsw + W_SK + (size_t)i * 2048;
      float4 a = ld_nt4(src + t * 8), b = ld_nt4(src + t * 8 + 4);
      uint4 o; o.x = pack2(a.x, a.y); o.y = pack2(a.z, a.w); o.z = pack2(b.x, b.y); o.w = pack2(b.z, b.w);
      *(uint4*)(dst + t * 8) = o;
      continue;
    }
    i -= N_SK;
    {
      int e = i * 256 + t;
      if (e < 4100 * 8) {
        int pi = e >> 3, fi = e & 7;
        int pos = pi < 4096 ? pi : 16384 + (pi - 4096);
        float inv = powf(500000.f, -(float)fi * 0.125f);
        float ang = (float)pos * inv;
        double tr = (double)ang * 0.15915494309189535;
        tr -= rint(tr);
        float fr = (float)tr;
        float2 cs; cs.x = __builtin_amdgcn_cosf(fr); cs.y = __builtin_amdgcn_sinf(fr);
        ((float2*)(p.ws + OFF_ROPE))[e] = cs;
      }
    }
  }
}

__device__ void phase_gemm1(CParams& p, char* smem) {
  EPI_VARS
  const bf16_t* A = (const bf16_t*)(p.ws + OFF_R1);
  const bf16_t* B = (const bf16_t*)(p.ws + OFF_W) + W_IN;
  bf16_t* zr = (bf16_t*)(p.ws + OFF_ZR);
  bf16_t* zg = (bf16_t*)(p.ws + OFF_ZG);
  const int x = blockIdx.x & 7, per = gridDim.x >> 3;
  if ((int)blockIdx.x >= per * 8) return;
  for (int q = blockIdx.x >> 3;; q += per) {
    int mt, nt;
    if (!tile_at(q, x, 4, 10, 22, 6, mt, nt)) break;
    f32x4 acc[4][6];
    zero_acc6(acc);
    gemm_loop3(acc, A + (size_t)mt * 192 * 2048, 2048, B + (size_t)nt * 128 * 2048, 2048, 2048, smem);
    const int n0 = nt * 128;
    const int act = (n0 < 1024) ? 0 : (n0 < 2048 ? 1 : (n0 < 3584 ? 0 : 2));
    bf16_t* dst; int ld, cb;
    if (n0 < 3584) { dst = zr; ld = 3584; cb = n0; } else { dst = zg; ld = 4096; cb = n0 - 3584; }
    if (act == 2) {
      uint4* gt = (uint4*)zg + ((size_t)(mt * 32 + (nt - 28)) * 12) * 256 + opaque_u(threadIdx.x);
#pragma unroll
      for (int mm = 0; mm < 6; mm++)
#pragma unroll
        for (int n2 = 0; n2 < 2; n2++) {
          uint4 o;
          o.x = pack2(sigmoidf_(acc[2 * n2][mm][0]), sigmoidf_(acc[2 * n2][mm][1]));
          o.y = pack2(sigmoidf_(acc[2 * n2][mm][2]), sigmoidf_(acc[2 * n2][mm][3]));
          o.z = pack2(sigmoidf_(acc[2 * n2 + 1][mm][0]), sigmoidf_(acc[2 * n2 + 1][mm][1]));
          o.w = pack2(sigmoidf_(acc[2 * n2 + 1][mm][2]), sigmoidf_(acc[2 * n2 + 1][mm][3]));
          gt[(mm * 2 + n2) * 256] = o;
        }
    } else {
      bf16_t* dt = dst + (size_t)mt * 192 * ld + cb;
      bf16_t (*T)[136] = (bf16_t (*)[136])smem;
      __syncthreads();
      const unsigned lrow = opaque_u(LROW3), lcol = opaque_u(LCOL2);
#pragma unroll
      for (int mm = 0; mm < 6; mm++)
#pragma unroll
        for (int nn = 0; nn < 4; nn++) {
          float v[4];
#pragma unroll
          for (int j = 0; j < 4; j++) {
            v[j] = acc[nn][mm][j];
            if (act == 1) v[j] = gelu_tanh(v[j]);
          }
          *(uint2*)&T[lrow + mm * 16][lcol + nn * 16] = make_uint2(pack2(v[0], v[1]), pack2(v[2], v[3]));
        }
      __syncthreads();
      const unsigned tt = opaque_u(threadIdx.x);
#pragma unroll
      for (int i = 0; i < 12; i++) {
        const unsigned c = tt + 256u * i, row = c >> 4, ch = (c & 15u) * 8u;
        *(uint4*)(dt + (size_t)row * ld + ch) = *(const uint4*)&T[row][ch];
      }
    }
  }
}

__device__ void rglru_tile(CParams& p, int mt, int jb, char* smem) {
  EPI_VARS
  bf16_t (*A2)[136] = (bf16_t (*)[136])smem;
  bf16_t (*B2)[136] = (bf16_t (*)[136])(smem + 34816);
  const bf16_t* zr = (const bf16_t*)(p.ws + OFF_ZR);
  const bf16_t* wsw = (const bf16_t*)(p.ws + OFF_W);
  float* a_arr = p.out;
  float* b_arr = p.out + (size_t)NTOK * 1024;
  const int t = threadIdx.x;
  const int c8 = (t & 15) * 8, r0 = t >> 4, ch0 = jb * 128 + c8;
  float cw[4][8], cbias[8];
#pragma unroll
  for (int k = 0; k < 4; k++)
#pragma unroll
    for (int j = 0; j < 8; j++) cw[k][j] = p.conv_w[k * 1024 + ch0 + j];
#pragma unroll
  for (int j = 0; j < 8; j++) cbias[j] = p.conv_b[ch0 + j];
  __syncthreads();
  for (int i = 0; i < 8; i++) {
    int r = r0 + 16 * i, tok = mt * 128 + r;
    float xc[8];
#pragma unroll
    for (int j = 0; j < 8; j++) xc[j] = cbias[j];
#pragma unroll
    for (int d = 0; d < 4; d++) {
      float xv[8];
      bool fromz, zero = false;
      int sidx = 0;
      if (tok < NPROMPT) { fromz = ((tok & 4095) >= d); zero = !fromz; }
      else { int s = tok - NPROMPT, dt = s & 3; fromz = (dt >= d); sidx = ((s >> 2) * 3 + (3 + dt - d)); }
      if (fromz) {
        uint4 u = *(const uint4*)(zr + (size_t)(tok - d) * 3584 + ch0);
        unpack8(u, xv);
      } else if (zero) {
#pragma unroll
        for (int j = 0; j < 8; j++) xv[j] = 0.f;
      } else {
        const float* sp = p.state_conv + (size_t)sidx * 1024 + ch0;
#pragma unroll
        for (int j = 0; j < 8; j++) xv[j] = sp[j];
      }
      if (d == 0) {
        if (tok < NPROMPT) {
          int ts = tok & 4095;
          if (ts >= 4093) {
            float* o = p.out + O_PCONV + (size_t)((tok >> 12) * 3 + (ts - 4093)) * 1024 + ch0;
#pragma unroll
            for (int j = 0; j < 8; j++) o[j] = xv[j];
          }
        } else {
          int s = tok - NPROMPT, dt = s & 3;
          if (dt >= 1) {
            float* o = p.out + O_SCONV + (size_t)((s >> 2) * 3 + (dt - 1)) * 1024 + ch0;
#pragma unroll
            for (int j = 0; j < 8; j++) o[j] = xv[j];
          }
        }
      }
#pragma unroll
      for (int j = 0; j < 8; j++) xc[j] += cw[3 - d][j] * xv[j];
    }
    *(uint4*)&A2[r][c8] = pack8(xc);
  }
  load_b2(B2, wsw + W_RG + jb * 16384);
  __syncthreads();
  f32x16 accr[2][2], acci[2][2];
  zero_acc(accr); zero_acc(acci);
  lds_gemm128(accr, A2, B2);
  __syncthreads();
  load_b2(B2, wsw + W_IG + jb * 16384);
  __syncthreads();
  lds_gemm128(acci, A2, B2);
  float* sumP = (float*)(p.ws + OFF_SUM);
  float* sumH = sumP + 524288;
  const int hh = lane >> 5;
#pragma unroll
  for (int j = 0; j < 2; j++) {
    int col = ACC_COL(j), ch = jb * 128 + col;
    float br = p.b_rgate[ch], bi = p.b_igate[ch];
    float sp = log1pf(__expf(-p.lru_lambda[ch]));
#pragma unroll
    for (int i = 0; i < 2; i++) {
      float Pq[4], Hq[4];
#pragma unroll
      for (int r = 0; r < 16; r++) {
        int row = ACC_ROW(i, r), tok = mt * 128 + row;
        float xcv = bf2f(A2[row][col]);
        float rg = __builtin_amdgcn_rcpf(1.f + __expf(-(accr[i][j][r] + br)));
        float ig = __builtin_amdgcn_rcpf(1.f + __expf(-(acci[i][j][r] + bi)));
        float la = -8.f * rg * sp;
        float a = __expf(la);
        float mult = (tok < NPROMPT && (tok & 4095) == 0) ? 1.f : sqrtf(fmaxf(1.f - a * a, 0.f));
        float bv = mult * ig * xcv;
        a_arr[(size_t)tok * 1024 + ch] = a;
        b_arr[(size_t)tok * 1024 + ch] = bv;
        if ((r & 3) == 0) { Pq[r >> 2] = a; Hq[r >> 2] = bv; }
        else { Pq[r >> 2] *= a; Hq[r >> 2] = Hq[r >> 2] * a + bv; }
      }
      if (mt < 128) {
        float P = 1.f, H = 0.f;
#pragma unroll
        for (int q = 0; q < 4; q++) {
          float Pp = __shfl_xor(Pq[q], 32), Hp = __shfl_xor(Hq[q], 32);
          float P1 = hh ? Pp : Pq[q], H1 = hh ? Hp : Hq[q];
          float P2 = hh ? Pq[q] : Pp, H2 = hh ? Hq[q] : Hp;
          H = H * P1 + H1; P *= P1;
          H = H * P2 + H2; P *= P2;
        }
        if (hh == 0) {
          int cid = mt * 4 + wm * 2 + i;
          sumP[(size_t)cid * 1024 + ch] = P;
          sumH[(size_t)cid * 1024 + ch] = H;
        }
      }
    }
  }
}

__device__ void attn_prompt_item(CParams& p, int b, int nb, int kvh, char* smem) {
  const int t = threadIdx.x, lane = t & 63, w = t >> 6;
  bf16_t (*Ks)[72] = (bf16_t (*)[72])smem;
  bf16_t (*Vt)[264] = (bf16_t (*)[264])(smem + 36864);
  const bf16_t* zr = (const bf16_t*)(p.ws + OFF_ZR);
  const float2* rope = (const float2*)(p.ws + OFF_ROPE);
  bf16_t* obuf = (bf16_t*)(p.ws + OFF_R1) + (size_t)NTOK * 1024;
  __syncthreads();
  {
    int jk = t;
    int ts = (nb - 1) * 128 + jk;
    if (ts >= 0) {
      int tok = b * 4096 + ts;
      const bf16_t* kp = zr + (size_t)tok * 3584 + 3072 + kvh * 64;
      const bf16_t* vp = zr + (size_t)tok * 3584 + 3328 + kvh * 64;
      const bool wout = (nb == 31 && jk >= 128);
      float* ok = p.out + O_PK + (size_t)((b * 128 + (jk - 128)) * 4 + kvh) * 64;
      float* ov = p.out + O_PV + (size_t)((b * 128 + (jk - 128)) * 4 + kvh) * 64;
      uint4 k0 = *(const uint4*)(kp), k1 = *(const uint4*)(kp + 8), k2 = *(const uint4*)(kp + 16), k3 = *(const uint4*)(kp + 24);
      uint4 k4 = *(const uint4*)(kp + 32), k5 = *(const uint4*)(kp + 40), k6 = *(const uint4*)(kp + 48), k7 = *(const uint4*)(kp + 56);
      float ss = 0.f;
#define SSQ8(u) { float f_[8]; unpack8(u, f_); for (int j_ = 0; j_ < 8; j_++) ss += f_[j_] * f_[j_]; }
      SSQ8(k0) SSQ8(k1) SSQ8(k2) SSQ8(k3) SSQ8(k4) SSQ8(k5) SSQ8(k6) SSQ8(k7)
      const float rs = rsqrtf(ss * (1.f / 64.f) + EPSF);
      {
        float f0[8], f1[8];
        unpack8(k0, f0); unpack8(k1, f1);
#pragma unroll
        for (int i = 0; i < 8; i++) {
          float x1 = f0[i] * rs * p.k_norm[i], x2 = f1[i] * rs * p.k_norm[8 + i];
          float2 cs = rope[ts * 8 + i];
          f0[i] = x1 * cs.x - x2 * cs.y;
          f1[i] = x2 * cs.x + x1 * cs.y;
        }
        *(uint4*)&Ks[jk][0] = pack8(f0);
        *(uint4*)&Ks[jk][8] = pack8(f1);
        if (wout) {
          *(float4*)(ok + 0) = make_float4(f0[0], f0[1], f0[2], f0[3]); *(float4*)(ok + 4) = make_float4(f0[4], f0[5], f0[6], f0[7]);
          *(float4*)(ok + 8) = make_float4(f1[0], f1[1], f1[2], f1[3]); *(float4*)(ok + 12) = make_float4(f1[4], f1[5], f1[6], f1[7]);
        }
      }
#define KREST(u, c) { float f_[8]; unpack8(u, f_); for (int j_ = 0; j_ < 8; j_++) f_[j_] = f_[j_] * rs * p.k_norm[(c) * 8 + j_]; \
        *(uint4*)&Ks[jk][(c) * 8] = pack8(f_); \
        if (wout) { *(float4*)(ok + (c) * 8) = make_float4(f_[0], f_[1], f_[2], f_[3]); *(float4*)(ok + (c) * 8 + 4) = make_float4(f_[4], f_[5], f_[6], f_[7]); } }
      KREST(k2, 2) KREST(k3, 3) KREST(k4, 4) KREST(k5, 5) KREST(k6, 6) KREST(k7, 7)
#pragma unroll 2
      for (int c = 0; c < 8; c++) {
        uint4 u = *(const uint4*)(vp + c * 8);
        Vt[c * 8 + 0][jk] = (bf16_t)(u.x & 0xffffu); Vt[c * 8 + 1][jk] = (bf16_t)(u.x >> 16);
        Vt[c * 8 + 2][jk] = (bf16_t)(u.y & 0xffffu); Vt[c * 8 + 3][jk] = (bf16_t)(u.y >> 16);
        Vt[c * 8 + 4][jk] = (bf16_t)(u.z & 0xffffu); Vt[c * 8 + 5][jk] = (bf16_t)(u.z >> 16);
        Vt[c * 8 + 6][jk] = (bf16_t)(u.w & 0xffffu); Vt[c * 8 + 7][jk] = (bf16_t)(u.w >> 16);
        if (wout) {
          float f_[8]; unpack8(u, f_);
          *(float4*)(ov + c * 8) = make_float4(f_[0], f_[1], f_[2], f_[3]); *(float4*)(ov + c * 8 + 4) = make_float4(f_[4], f_[5], f_[6], f_[7]);
        }
      }
    } else {
      uint4 z4 = make_uint4(0, 0, 0, 0);
#pragma unroll
      for (int c = 0; c < 8; c++) *(uint4*)&Ks[jk][c * 8] = z4;
#pragma unroll
      for (int d = 0; d < 64; d++) Vt[d][jk] = 0;
    }
  }
  __syncthreads();
  const int r = lane & 31, h = lane >> 5;
  const int iq = 32 * w + r;
  const int tsq = nb * 128 + iq;
  const int tokq = b * 4096 + tsq;
#pragma unroll 1
  for (int g = 0; g < 4; g++) {
    asm volatile("" ::: "memory");
    const int qh = kvh * 4 + g;
    float qf[4][8];
    const bf16_t* qp = zr + (size_t)tokq * 3584 + 2048 + qh * 64 + 8 * h;
    float ss = 0.f;
#pragma unroll
    for (int kk = 0; kk < 4; kk++) {
      uint4 u = *(const uint4*)(qp + kk * 16);
      unpack8(u, qf[kk]);
#pragma unroll
      for (int j = 0; j < 8; j++) ss += qf[kk][j] * qf[kk][j];
    }
    ss += __shfl_xor(ss, 32);
    float rs = rsqrtf(ss * (1.f / 64.f) + EPSF);
#pragma unroll
    for (int kk = 0; kk < 4; kk++)
#pragma unroll
      for (int j = 0; j < 8; j++) qf[kk][j] = qf[kk][j] * rs * p.q_norm[kk * 16 + 8 * h + j];
#pragma unroll
    for (int j = 0; j < 8; j++) {
      float2 cs = rope[tsq * 8 + j];
      float mine = qf[0][j];
      float other = __shfl_xor(mine, 32);
      qf[0][j] = (h == 0) ? (mine * cs.x - other * cs.y) : (mine * cs.x + other * cs.y);
    }
    bf16x8 bq[4];
#pragma unroll
    for (int kk = 0; kk < 4; kk++) {
      float f[8];
#pragma unroll
      for (int j = 0; j < 8; j++) f[j] = qf[kk][j] * 0.125f;
      uint4 u = pack8(f);
      bq[kk] = *(bf16x8*)&u;
    }
    f32x16 s[5];
#pragma unroll
    for (int kt = 0; kt < 5; kt++) {
#pragma unroll
      for (int e = 0; e < 16; e++) s[kt][e] = 0.f;
#pragma unroll
      for (int kk = 0; kk < 4; kk++) {
        bf16x8 a = *(const bf16x8*)&Ks[32 * (w + kt) + r][kk * 16 + 8 * h];
        s[kt] = __builtin_amdgcn_mfma_f32_32x32x16_bf16(a, bq[kk], s[kt], 0, 0, 0);
      }
    }
    const float sink = p.attn_sinks[qh];
    float m = -3e38f;
#pragma unroll
    for (int e = 0; e < 16; e++) {
      int jr = (e & 3) + 8 * (e >> 2) + 4 * h;
      s[0][e] = (jr > r) ? s[0][e] : -1e30f;
      s[4][e] = (jr <= r) ? s[4][e] : -1e30f;
    }
    if (nb == 0) {
#pragma unroll
      for (int kt = 0; kt < 4; kt++)
        if (w + kt < 4) {
#pragma unroll
          for (int e = 0; e < 16; e++) s[kt][e] = -1e30f;
        }
    }
#pragma unroll
    for (int kt = 0; kt < 5; kt++)
#pragma unroll
      for (int e = 0; e < 16; e++) m = fmaxf(m, s[kt][e]);
    m = fmaxf(m, __shfl_xor(m, 32));
    m = fmaxf(m, sink);
    float l = 0.f;
#pragma unroll
    for (int kt = 0; kt < 5; kt++)
#pragma unroll
      for (int e = 0; e < 16; e++) { float pv = __expf(s[kt][e] - m); s[kt][e] = pv; l += pv; }
    l += __shfl_xor(l, 32);
    l += __expf(sink - m);
    const float linv = 1.f / l;
    f32x16 o[2];
#pragma unroll
    for (int e = 0; e < 16; e++) { o[0][e] = 0.f; o[1][e] = 0.f; }
#pragma unroll
    for (int kt = 0; kt < 5; kt++)
#pragma unroll
      for (int u2 = 0; u2 < 2; u2++) {
        float f[8];
#pragma unroll
        for (int j = 0; j < 8; j++) f[j] = s[kt][8 * u2 + j];
        uint4 pu = pack8(f);
        bf16x8 pb = *(bf16x8*)&pu;
        int kb = 32 * (w + kt) + 16 * u2 + 4 * h;
#pragma unroll
        for (int dt = 0; dt < 2; dt++) {
          uint2 v0 = *(const uint2*)&Vt[32 * dt + r][kb];
          uint2 v1 = *(const uint2*)&Vt[32 * dt + r][kb + 8];
          uint4 va = make_uint4(v0.x, v0.y, v1.x, v1.y);
          o[dt] = __builtin_amdgcn_mfma_f32_32x32x16_bf16(*(bf16x8*)&va, pb, o[dt], 0, 0, 0);
        }
      }
    bf16_t* op = obuf + (size_t)tokq * 1024 + qh * 64;
#pragma unroll
    for (int dt = 0; dt < 2; dt++)
#pragma unroll
      for (int e4 = 0; e4 < 4; e4++) {
        int d = 32 * dt + 8 * e4 + 4 * h;
        uint2 st;
        st.x = pack2(o[dt][4 * e4 + 0] * linv, o[dt][4 * e4 + 1] * linv);
        st.y = pack2(o[dt][4 * e4 + 2] * linv, o[dt][4 * e4 + 3] * linv);
        *(uint2*)(op + d) = st;
      }
  }
}

__device__ void attn_sample_item(CParams& p, int db, char* smem) {
  const int t = threadIdx.x, lane = t & 63, w = t >> 6;
  const int kvh = w;
  float* qs = (float*)smem + w * 1024;
  float* knew = (float*)smem + 4096 + w * 256;
  float* vnew = (float*)smem + 5120 + w * 256;
  float* ps = (float*)smem + 6144 + w * (16 * 132);
  const bf16_t* zr = (const bf16_t*)(p.ws + OFF_ZR);
  const float2* rope = (const float2*)(p.ws + OFF_ROPE);
  bf16_t* obuf = (bf16_t*)(p.ws + OFF_R1) + (size_t)NTOK * 1024;
  const int tok0 = NPROMPT + db * 4;
  __syncthreads();
  {
    int row = lane >> 4, part = lane & 15, d0 = part * 4;
    const bf16_t* kp = zr + (size_t)(tok0 + row) * 3584 + 3072 + kvh * 64 + d0;
    const bf16_t* vp = zr + (size_t)(tok0 + row) * 3584 + 3328 + kvh * 64 + d0;
    uint2 ku = *(const uint2*)kp, vu = *(const uint2*)vp;
    float kf[4] = {lo2f(ku.x), hi2f(ku.x), lo2f(ku.y), hi2f(ku.y)};
    float vf[4] = {lo2f(vu.x), hi2f(vu.x), lo2f(vu.y), hi2f(vu.y)};
    float ss = kf[0] * kf[0] + kf[1] * kf[1] + kf[2] * kf[2] + kf[3] * kf[3];
    ss += __shfl_xor(ss, 1); ss += __shfl_xor(ss, 2); ss += __shfl_xor(ss, 4); ss += __shfl_xor(ss, 8);
    float rs = rsqrtf(ss * (1.f / 64.f) + EPSF);
#pragma unroll
    for (int j = 0; j < 4; j++) kf[j] = kf[j] * rs * p.k_norm[d0 + j];
#pragma unroll
    for (int j = 0; j < 4; j++) {
      float other = __shfl_xor(kf[j], 2);
      if (part < 4) {
        float2 cs = rope[(4096 + row) * 8 + ((d0 + j) & 7)];
        kf[j] = (part < 2) ? (kf[j] * cs.x - other * cs.y) : (kf[j] * cs.x + other * cs.y);
      }
    }
    float* ok = p.out + O_SK + (size_t)((db * 128 + 124 + row) * 4 + kvh) * 64 + d0;
    float* ov = p.out + O_SV + (size_t)((db * 128 + 124 + row) * 4 + kvh) * 64 + d0;
#pragma unroll
    for (int j = 0; j < 4; j++) { knew[row * 64 + d0 + j] = kf[j]; vnew[row * 64 + d0 + j] = vf[j]; ok[j] = kf[j]; ov[j] = vf[j]; }
  }
  {
    int qrow = lane >> 2, part = lane & 3, g = qrow >> 2, tq = qrow & 3, d0 = part * 16;
    int qh = kvh * 4 + g;
    const bf16_t* qp = zr + (size_t)(tok0 + tq) * 3584 + 2048 + qh * 64 + d0;
    float qf[16];
    unpack8(*(const uint4*)qp, qf); unpack8(*(const uint4*)(qp + 8), qf + 8);
    float ss = 0.f;
#pragma unroll
    for (int j = 0; j < 16; j++) ss += qf[j] * qf[j];
    ss += __shfl_xor(ss, 1); ss += __shfl_xor(ss, 2);
    float rs = rsqrtf(ss * (1.f / 64.f) + EPSF);
#pragma unroll
    for (int j = 0; j < 16; j++) qf[j] = qf[j] * rs * p.q_norm[d0 + j];
    if (part == 0) {
#pragma unroll
      for (int i = 0; i < 8; i++) {
        float2 cs = rope[(4096 + tq) * 8 + i];
        float x1 = qf[i], x2 = qf[i + 8];
        qf[i] = x1 * cs.x - x2 * cs.y;
        qf[i + 8] = x2 * cs.x + x1 * cs.y;
      }
    }
#pragma unroll
    for (int j = 0; j < 16; j++) qs[qrow * 64 + d0 + j] = qf[j] * 0.125f;
  }
  __syncthreads();
#pragma unroll 1
  for (int sl = 0; sl < 3; sl++) {
    int j = lane + 64 * sl;
    if (j < 132) {
      float scq[16];
#pragma unroll
      for (int q = 0; q < 16; q++) scq[q] = 0.f;
      const float* kr = (j < 128) ? p.cache_k + (size_t)((db * 128 + j) * 4 + kvh) * 64 : knew + (j - 128) * 64;
#pragma unroll 2
      for (int d = 0; d < 64; d += 4) {
        float4 kv = *(const float4*)(kr + d);
        if (j >= 4 && j < 128) *(float4*)(p.out + O_SK + (size_t)((db * 128 + j - 4) * 4 + kvh) * 64 + d) = kv;
#pragma unroll
        for (int q = 0; q < 16; q++) {
          float4 qv = *(const float4*)(qs + q * 64 + d);
          scq[q] += kv.x * qv.x + kv.y * qv.y + kv.z * qv.z + kv.w * qv.w;
        }
      }
#pragma unroll
      for (int q = 0; q < 16; q++) ps[q * 132 + j] = scq[q];
    }
  }
#pragma unroll 1
  for (int q = 0; q < 16; q++) {
    int g = q >> 2, tq = q & 3;
    float sink = p.attn_sinks[kvh * 4 + g];
    float m = -3e38f;
    float sv[3];
#pragma unroll
    for (int sl = 0; sl < 3; sl++) {
      int j = lane + 64 * sl;
      bool valid = (j < 132) && (j >= tq + 1) && (j <= tq + 128);
      float v = valid ? ps[q * 132 + j] : -1e30f;
      sv[sl] = v;
      m = fmaxf(m, v);
    }
    m = fmaxf(wave_max(m), sink);
    float l = 0.f;
#pragma unroll
    for (int sl = 0; sl < 3; sl++) { float pv = __expf(sv[sl] - m); sv[sl] = pv; l += pv; }
    l = wave_sum(l) + __expf(sink - m);
    float linv = 1.f / l;
#pragma unroll
    for (int sl = 0; sl < 3; sl++) {
      int j = lane + 64 * sl;
      if (j < 132) ps[q * 132 + j] = sv[sl] * linv;
    }
  }
  __syncthreads();
  float oacc[16];
#pragma unroll
  for (int q = 0; q < 16; q++) oacc[q] = 0.f;
  for (int j = 0; j < 132; j++) {
    float vv;
    if (j < 128) {
      vv = p.cache_v[(size_t)((db * 128 + j) * 4 + kvh) * 64 + lane];
      if (j >= 4) p.out[O_SV + (size_t)((db * 128 + j - 4) * 4 + kvh) * 64 + lane] = vv;
    } else vv = vnew[(j - 128) * 64 + lane];
#pragma unroll
    for (int q = 0; q < 16; q++) oacc[q] += ps[q * 132 + j] * vv;
  }
#pragma unroll
  for (int q = 0; q < 16; q++) {
    int g = q >> 2, tq = q & 3;
    obuf[(size_t)(tok0 + tq) * 1024 + (kvh * 4 + g) * 64 + lane] = f2bf(oacc[q]);
  }
}

#ifndef ONLY2
#define ONLY2 -1
#endif
#define P2_ON(n) (true)
__device__ void phase_mix(CParams& p, char* smem) {
  if (P2_ON(0))
    for (int it = blockIdx.x; it < 512; it += gridDim.x) {
      CParams& q = *get_params();
      attn_prompt_item(q, it >> 7, (it >> 2) & 31, it & 3, smem);
    }
  if (P2_ON(1))
    for (int it = blockIdx.x; it < 1056; it += gridDim.x) {
      CParams& q = *get_params();
      rglru_tile(q, it >> 3, it & 7, smem);
    }
  if (P2_ON(2))
    for (int it = (int)gridDim.x - 1 - (int)blockIdx.x; it < 128; it += gridDim.x) {
      CParams& q = *get_params();
      attn_sample_item(q, it, smem);
    }
}

__device__ void phase_scan1(CParams& p) {}
__device__ void phase_scan2(CParams& p) {
  const float* a_arr = p.out;
  const float* b_arr = p.out + (size_t)NTOK * 1024;
  const float* sumP = (const float*)(p.ws + OFF_SUM);
  const float* sumH = sumP + 524288;
  const bf16_t* zr = (const bf16_t*)(p.ws + OFF_ZR);
  bf16_t* hg = (bf16_t*)(p.ws + OFF_R1);
  for (int it = blockIdx.x; it < 512 + 512; it += gridDim.x) {
    if (it < 512) {
      int id = it * 256 + threadIdx.x;
      int ch = id & 1023, cg = (id >> 10) & 31, b = id >> 15;
      float h = 0.f;
      const float* sp = sumP + (size_t)(b * 128) * 1024 + ch;
      const float* sh = sumH + (size_t)(b * 128) * 1024 + ch;
      {
        const int nprev = cg * 4;
        int c = 0;
        for (; c + 16 <= nprev; c += 16) {
          float pp[16], ph_[16];
#pragma unroll
          for (int u = 0; u < 16; u++) { pp[u] = sp[(size_t)(c + u) * 1024]; ph_[u] = sh[(size_t)(c + u) * 1024]; }
#pragma unroll
          for (int u = 0; u < 16; u++) h = pp[u] * h + ph_[u];
        }
        for (; c < nprev; c++) h = sp[(size_t)c * 1024] * h + sh[(size_t)c * 1024];
      }
#pragma unroll 1
      for (int sub = 0; sub < 4; sub++) {
        size_t tok0 = (size_t)b * 4096 + (cg * 4 + sub) * 32;
        float av[32], bv[32], gv[32];
#pragma unroll
        for (int s2 = 0; s2 < 32; s2++) {
          size_t tok = tok0 + s2;
          av[s2] = a_arr[tok * 1024 + ch];
          bv[s2] = b_arr[tok * 1024 + ch];
          gv[s2] = bf2f(zr[tok * 3584 + 1024 + ch]);
        }
#pragma unroll
        for (int s2 = 0; s2 < 32; s2++) {
          h = av[s2] * h + bv[s2];
          hg[(tok0 + s2) * 1024 + ch] = f2bf(h * gv[s2]);
        }
      }
      if (cg == 31) p.out[O_PRG + b * 1024 + ch] = h;
    } else {
      int id = (it - 512) * 256 + threadIdx.x;
      int ch = id & 1023, db = id >> 10;
      float h = p.state_rglru[db * 1024 + ch];
#pragma unroll
      for (int dt = 0; dt < 4; dt++) {
        size_t tok = NPROMPT + db * 4 + dt;
        h = a_arr[tok * 1024 + ch] * h + b_arr[tok * 1024 + ch];
        float gg = bf2f(zr[tok * 3584 + 1024 + ch]);
        hg[tok * 1024 + ch] = f2bf(h * gg);
      }
      p.out[O_SRG + db * 1024 + ch] = h;
    }
  }
}

__device__ void phase_proj(CParams& p, char* smem) {
  EPI_VARS
  const bf16_t* hg = (const bf16_t*)(p.ws + OFF_R1);
  const bf16_t* ob = hg + (size_t)NTOK * 1024;
  const bf16_t* wsw = (const bf16_t*)(p.ws + OFF_W);
  const bf16_t* zg = (const bf16_t*)(p.ws + OFF_ZG);
  bf16_t* merged = (bf16_t*)(p.ws + OFF_ZR);
  const int x = blockIdx.x & 7, per = gridDim.x >> 3;
  if ((int)blockIdx.x >= per * 8) return;
  for (int q = blockIdx.x >> 3;; q += per) {
    int mt, nt;
    if (!tile_at(q, x, 1, 16, 88, 1, mt, nt)) break;
    f32x4 acc[4][6];
    zero_acc6(acc);
    gemm_loop3(acc, hg + (size_t)mt * 192 * 1024, 1024, wsw + W_RNN + (size_t)nt * 128 * 1024, 1024, 1024, smem);
    {
    const uint4* gat = (const uint4*)zg + ((size_t)(mt * 32 + nt) * 12) * 256 + opaque_u(threadIdx.x);
    uint4* ptl = (uint4*)p.out + ((size_t)(mt * 16 + nt) * 12) * 256 + opaque_u(threadIdx.x);
#pragma unroll
    for (int mm = 0; mm < 6; mm++)
#pragma unroll
      for (int n2 = 0; n2 < 2; n2++) {
        const uint4 g = gat[(mm * 2 + n2) * 256];
        uint4 o;
        o.x = pack2(acc[2 * n2][mm][0] * lo2f(g.x), acc[2 * n2][mm][1] * hi2f(g.x));
        o.y = pack2(acc[2 * n2][mm][2] * lo2f(g.y), acc[2 * n2][mm][3] * hi2f(g.y));
        o.z = pack2(acc[2 * n2 + 1][mm][0] * lo2f(g.z), acc[2 * n2 + 1][mm][1] * hi2f(g.z));
        o.w = pack2(acc[2 * n2 + 1][mm][2] * lo2f(g.w), acc[2 * n2 + 1][mm][3] * hi2f(g.w));
        ptl[(mm * 2 + n2) * 256] = o;
      }
    }
    zero_acc6(acc);
    gemm_loop3(acc, ob + (size_t)mt * 192 * 1024, 1024, wsw + W_ATT + (size_t)nt * 128 * 1024, 1024, 1024, smem);
    asm volatile("" ::: "memory");
    {
      bf16_t (*T)[136] = (bf16_t (*)[136])smem;
      __syncthreads();
      const uint4* gbt = (const uint4*)zg + ((size_t)(mt * 32 + 16 + nt) * 12) * 256 + opaque_u(threadIdx.x);
      const uint4* ptl = (const uint4*)p.out + ((size_t)(mt * 16 + nt) * 12) * 256 + opaque_u(threadIdx.x);
      bf16_t* mgt = merged + (size_t)mt * 192 * 2048 + nt * 128;
      const unsigned lrow = opaque_u(LROW3), lcol = opaque_u(LCOL2);
#pragma unroll
      for (int mm = 0; mm < 6; mm++)
#pragma unroll
        for (int n2 = 0; n2 < 2; n2++) {
          const uint4 g = gbt[(mm * 2 + n2) * 256];
          const uint4 pm = ptl[(mm * 2 + n2) * 256];
          *(uint2*)&T[lrow + mm * 16][lcol + (2 * n2) * 16] =
              make_uint2(pack2(lo2f(pm.x) + acc[2 * n2][mm][0] * lo2f(g.x), hi2f(pm.x) + acc[2 * n2][mm][1] * hi2f(g.x)),
                         pack2(lo2f(pm.y) + acc[2 * n2][mm][2] * lo2f(g.y), hi2f(pm.y) + acc[2 * n2][mm][3] * hi2f(g.y)));
          *(uint2*)&T[lrow + mm * 16][lcol + (2 * n2 + 1) * 16] =
              make_uint2(pack2(lo2f(pm.z) + acc[2 * n2 + 1][mm][0] * lo2f(g.z), hi2f(pm.z) + acc[2 * n2 + 1][mm][1] * hi2f(g.z)),
                         pack2(lo2f(pm.w) + acc[2 * n2 + 1][mm][2] * lo2f(g.w), hi2f(pm.w) + acc[2 * n2 + 1][mm][3] * hi2f(g.w)));
        }
      __syncthreads();
      const unsigned tt = opaque_u(threadIdx.x);
#pragma unroll
      for (int i = 0; i < 12; i++) {
        const unsigned c = tt + 256u * i, row = c >> 4, ch = (c & 15u) * 8u;
        *(uint4*)(mgt + (size_t)row * 2048 + ch) = *(const uint4*)&T[row][ch];
      }
    }
  }
}

__device__ void phase_wout(CParams& p, char* smem) {
  EPI_VARS
  const bf16_t* merged = (const bf16_t*)(p.ws + OFF_ZR);
  const bf16_t* wsw = (const bf16_t*)(p.ws + OFF_W);
  bf16_t* x1b = (bf16_t*)(p.ws + OFF_R1);
  const int x = blockIdx.x & 7, per = gridDim.x >> 3;
  if ((int)blockIdx.x >= per * 8) return;
  for (int q = blockIdx.x >> 3;; q += per) {
    int mt, nt;
    if (!tile_at(q, x, 1, 16, 88, 1, mt, nt)) break;
    f32x4 acc[4][6];
    zero_acc6(acc);
    gemm_loop3(acc, merged + (size_t)mt * 192 * 2048, 2048, wsw + W_OUT + (size_t)nt * 128 * 2048, 2048, 2048, smem);
    float* yt = p.out + O_Y + (size_t)mt * 192 * 2048 + nt * 128;
    bf16_t* xbt = x1b + (size_t)mt * 192 * 2048 + nt * 128;
    const unsigned lo = opaque_u(LROW3 * 2048 + LCOL2);
    const int colx = nt * 128 + LCOL2;
    bf16_t (*T)[136] = (bf16_t (*)[136])smem;
    __syncthreads();
    const unsigned lrow = opaque_u(LROW3), lcol = opaque_u(LCOL2);
#pragma unroll
    for (int mm = 0; mm < 6; mm++) {
      const float* xr = x_row(p, mt * 192 + LROW3 + mm * 16) + colx;
#pragma unroll
      for (int nn = 0; nn < 4; nn++) {
        unsigned o = lo + (unsigned)(mm * 16 * 2048 + nn * 16);
        float4 xv = *(const float4*)(xr + nn * 16);
        float4 v = make_float4(xv.x + acc[nn][mm][0], xv.y + acc[nn][mm][1], xv.z + acc[nn][mm][2], xv.w + acc[nn][mm][3]);
        *(float4*)(yt + o) = v;
        *(uint2*)&T[lrow + mm * 16][lcol + nn * 16] = make_uint2(pack2(v.x, v.y), pack2(v.z, v.w));
      }
    }
    __syncthreads();
    const unsigned tt = opaque_u(threadIdx.x);
#pragma unroll
    for (int i = 0; i < 12; i++) {
      const unsigned c = tt + 256u * i, row = c >> 4, ch = (c & 15u) * 8u;
      *(uint4*)(xbt + (size_t)row * 2048 + ch) = *(const uint4*)&T[row][ch];
    }
  }
}

__device__ void phase_pq(CParams& p, char* smem) {
  EPI_VARS
  const bf16_t* x1b = (const bf16_t*)(p.ws + OFF_R1);
  const bf16_t* wsw = (const bf16_t*)(p.ws + OFF_W);
  float* scores = (float*)(p.ws + OFF_ZG);
  bf16_t (*A2)[136] = (bf16_t (*)[136])smem;
  bf16_t (*B2)[136] = (bf16_t (*)[136])(smem + 34816);
  const int x = blockIdx.x & 7, per = gridDim.x >> 3;
  if ((int)blockIdx.x >= per * 8) return;
  for (int q = blockIdx.x >> 3;; q += per) {
    int mt, nt;
    if (!tile_at(q, x, 1, 16, 132, 1, mt, nt)) break;
    {
      f32x4 acc4[4][4];
      zero_acc4(acc4);
      gemm_loop(acc4, x1b + (size_t)mt * 128 * 2048, 2048, wsw + W_PQ + (size_t)nt * 128 * 2048, 2048, 2048, smem);
      __syncthreads();
#pragma unroll
      for (int mm = 0; mm < 4; mm++)
#pragma unroll
        for (int nn = 0; nn < 4; nn++)
          *(uint2*)&A2[LROW2 + mm * 16][LCOL2 + nn * 16] =
              make_uint2(pack2(acc4[nn][mm][0], acc4[nn][mm][1]), pack2(acc4[nn][mm][2], acc4[nn][mm][3]));
    }
    load_b2(B2, wsw + W_SK + (size_t)nt * 16384);
    __syncthreads();
    f32x16 acc[2][2];
    zero_acc(acc);
    lds_gemm128(acc, A2, B2);
    bf16_t* sct = (bf16_t*)scores + (size_t)mt * 128 * 2048 + nt * 128;
    bf16_t (*S)[136] = (bf16_t (*)[136])smem;
    __syncthreads();
    {
      const unsigned lrow = opaque_u(LROW), lcol = opaque_u(LCOL);
#pragma unroll
      for (int i = 0; i < 2; i++)
#pragma unroll
        for (int j = 0; j < 2; j++)
#pragma unroll
          for (int r = 0; r < 16; r++) S[lrow + ROWC(i, r)][lcol + j * 32] = f2bf(acc[i][j][r]);
    }
    __syncthreads();
    {
      const unsigned tt = opaque_u(threadIdx.x);
#pragma unroll
      for (int i = 0; i < 8; i++) {
        const unsigned c = tt + 256u * i, row = c >> 4, ch = (c & 15u) * 8u;
        *(uint4*)(sct + (size_t)row * 2048 + ch) = *(const uint4*)&S[row][ch];
      }
    }
  }
}

__device__ __forceinline__ unsigned f2key(float f) {
  unsigned u = __float_as_uint(f);
  return (u & 0x80000000u) ? ~u : (u | 0x80000000u);
}
#define WAVE_LDS_SYNC() asm volatile("s_waitcnt lgkmcnt(0)" ::: "memory")
template <int NV>
__device__ __forceinline__ void wave_top16(const unsigned (&key)[NV], bool (&sel)[NV], int (&pos)[NV], int lane) {
  unsigned prefix = 0;
  int bit = 31;
  bool done = false;
  {
    int c0 = 0, c1 = 0, c2 = 0, c3 = 0, c4 = 0, c5 = 0;
#pragma unroll
    for (int m = 0; m < NV; m++) {
      c0 += __popcll(__ballot(key[m] >= 0xBF000000u));
      c1 += __popcll(__ballot(key[m] >= 0xBF800000u));
      c2 += __popcll(__ballot(key[m] >= 0xC0000000u));
      c3 += __popcll(__ballot(key[m] >= 0xC0800000u));
      c4 += __popcll(__ballot(key[m] >= 0xC1000000u));
      c5 += __popcll(__ballot(key[m] >= 0xC1800000u));
    }
    if (c0 >= 16 && c5 < 16) {
      unsigned pf = 0xBF000000u; int cp = c0;
      if (c1 >= 16) { pf = 0xBF800000u; cp = c1; }
      if (c2 >= 16) { pf = 0xC0000000u; cp = c2; }
      if (c3 >= 16) { pf = 0xC0800000u; cp = c3; }
      if (c4 >= 16) { pf = 0xC1000000u; cp = c4; }
      prefix = pf;
      bit = 22;
      done = (cp == 16);
    }
  }
  for (; bit >= 0 && !done; --bit) {
    unsigned T = prefix | (1u << bit);
    int cnt = 0;
#pragma unroll
    for (int m = 0; m < NV; m++) cnt += __popcll(__ballot(key[m] >= T));
    if (cnt >= 16) prefix = T;
    if (cnt == 16) break;
  }
  const unsigned long long lt = (1ull << lane) - 1ull;
  int ngt = 0;
#pragma unroll
  for (int m = 0; m < NV; m++) ngt += __popcll(__ballot(key[m] > prefix));
  const int need = 16 - ngt;
  int eqb = 0, selb = 0;
#pragma unroll
  for (int m = 0; m < NV; m++) {
    bool gt = key[m] > prefix, eq = key[m] == prefix;
    unsigned long long em = __ballot(eq);
    int er = eqb + __popcll(em & lt);
    bool s = gt || (eq && er < need);
    unsigned long long sm = __ballot(s);
    sel[m] = s;
    pos[m] = selb + __popcll(sm & lt);
    eqb += __popcll(em);
    selb += __popcll(sm);
  }
}

__device__ void peer_token(CParams& p, int tok, char* smem) {
  const int t = threadIdx.x, lane = t & 63, w = t >> 6;
  float* s_sc = (float*)smem;
  float* s_part = s_sc + 2048;
  float* s_red = s_part + 8192;
  float* s_sel_s = s_red + 64;
  int* s_sel_i = (int*)(s_sel_s + 128);
  float* s_ew = (float*)(s_sel_i + 128);
  int* s_ei = (int*)(s_ew + 128);
  const bf16_t* scores = (const bf16_t*)(p.ws + OFF_ZG) + (size_t)tok * 2048;
  float* yrow = p.out + O_Y + (size_t)tok * 2048;
  __syncthreads();
  float4 xa = *(const float4*)(yrow + t * 8), xb = *(const float4*)(yrow + t * 8 + 4);
  float ss = xa.x * xa.x + xa.y * xa.y + xa.z * xa.z + xa.w * xa.w + xb.x * xb.x + xb.y * xb.y + xb.z * xb.z + xb.w * xb.w;
  ss = wave_sum(ss);
  if (lane == 0) s_red[w] = ss;
  {
    float sf[8];
    unpack8(*(const uint4*)(scores + t * 8), sf);
    *(float4*)(s_sc + t * 8) = make_float4(sf[0], sf[1], sf[2], sf[3]);
    *(float4*)(s_sc + t * 8 + 4) = make_float4(sf[4], sf[5], sf[6], sf[7]);
  }
  __syncthreads();
  const float rs = rsqrtf((s_red[0] + s_red[1] + s_red[2] + s_red[3]) * (1.f / 2048.f) + EPSF);
  float xn[32];
#pragma unroll
  for (int c = 0; c < 2; c++)
#pragma unroll
    for (int q4 = 0; q4 < 4; q4++) {
      float4 a = *(const float4*)(yrow + c * 1024 + lane * 16 + q4 * 4);
      float4 g = *(const float4*)(p.norm_ffn + c * 1024 + lane * 16 + q4 * 4);
      xn[c * 16 + q4 * 4 + 0] = a.x * rs * g.x; xn[c * 16 + q4 * 4 + 1] = a.y * rs * g.y;
      xn[c * 16 + q4 * 4 + 2] = a.z * rs * g.z; xn[c * 16 + q4 * 4 + 3] = a.w * rs * g.w;
    }
  for (int hh = 0; hh < 2; hh++) {
    const int h = 2 * w + hh;
#pragma unroll
    for (int pp = 0; pp < 2; pp++) {
      const int base = (h * 2 + pp) * 128;
      float v[2] = {s_sc[base + lane], s_sc[base + 64 + lane]};
      unsigned key[2] = {f2key(v[0]), f2key(v[1])};
      bool sel[2]; int pos[2];
      wave_top16<2>(key, sel, pos, lane);
#pragma unroll
      for (int m = 0; m < 2; m++)
        if (sel[m]) { s_sel_s[(w * 2 + pp) * 16 + pos[m]] = v[m]; s_sel_i[(w * 2 + pp) * 16 + pos[m]] = lane + 64 * m; }
    }
    WAVE_LDS_SYNC();
    {
      float s2v = s_sel_s[(w * 2 + 1) * 16 + (lane & 15)];
      float cand[4]; unsigned key[4]; bool sel[4]; int pos[4];
#pragma unroll
      for (int m = 0; m < 4; m++) { cand[m] = s_sel_s[(w * 2) * 16 + (lane >> 4) + 4 * m] + s2v; key[m] = f2key(cand[m]); }
      wave_top16<4>(key, sel, pos, lane);
#pragma unroll
      for (int m = 0; m < 4; m++)
        if (sel[m]) {
          s_ew[h * 16 + pos[m]] = cand[m];
          s_ei[h * 16 + pos[m]] = s_sel_i[(w * 2) * 16 + (lane >> 4) + 4 * m] * 128 + s_sel_i[(w * 2 + 1) * 16 + (lane & 15)];
        }
    }
    WAVE_LDS_SYNC();
    {
      float val = s_ew[h * 16 + (lane & 15)] * rs;
      float m = val;
      m = fmaxf(m, __shfl_xor(m, 1)); m = fmaxf(m, __shfl_xor(m, 2)); m = fmaxf(m, __shfl_xor(m, 4)); m = fmaxf(m, __shfl_xor(m, 8));
      float e = __expf(val - m);
      float sum = e;
      sum += __shfl_xor(sum, 1); sum += __shfl_xor(sum, 2); sum += __shfl_xor(sum, 4); sum += __shfl_xor(sum, 8);
      if (lane < 16) s_ew[h * 16 + lane] = e / sum;
    }
    WAVE_LDS_SYNC();
  }
  float acc[32];
#pragma unroll
  for (int j = 0; j < 32; j++) acc[j] = 0.f;
#define FP8_DOT(u4, xo, hacc) {                                                        \
    const unsigned d_[4] = {u4.x, u4.y, u4.z, u4.w};                                    \
    for (int q_ = 0; q_ < 4; q_++) {                                                    \
      auto lo_ = __builtin_amdgcn_cvt_pk_f32_fp8((int)d_[q_], false);                   \
      auto hi_ = __builtin_amdgcn_cvt_pk_f32_fp8((int)d_[q_], true);                    \
      hacc += lo_[0] * xn[(xo) + q_ * 4 + 0] + lo_[1] * xn[(xo) + q_ * 4 + 1] +         \
              hi_[0] * xn[(xo) + q_ * 4 + 2] + hi_[1] * xn[(xo) + q_ * 4 + 3];          \
    } }
#define FP8_AXPY(u4, xo, wgt) {                                                        \
    const unsigned d_[4] = {u4.x, u4.y, u4.z, u4.w};                                    \
    for (int q_ = 0; q_ < 4; q_++) {                                                    \
      auto lo_ = __builtin_amdgcn_cvt_pk_f32_fp8((int)d_[q_], false);                   \
      auto hi_ = __builtin_amdgcn_cvt_pk_f32_fp8((int)d_[q_], true);                    \
      acc[(xo) + q_ * 4 + 0] += wgt * lo_[0]; acc[(xo) + q_ * 4 + 1] += wgt * lo_[1];   \
      acc[(xo) + q_ * 4 + 2] += wgt * hi_[0]; acc[(xo) + q_ * 4 + 3] += wgt * hi_[1];   \
    } }
  const unsigned char* U8 = (const unsigned char*)(p.ws + OFF_U);
  const unsigned char* V8 = (const unsigned char*)(p.ws + OFF_V);
  uint4 ru[4][2], rv[4][2];
  float g[4];
  {
#pragma unroll
    for (int u = 0; u < 4; u++) {
      const int e = s_ei[w * 32 + u];
      g[u] = s_ew[w * 32 + u];
      const uint4* up = (const uint4*)(U8 + (size_t)e * 2048) + lane;
      ru[u][0] = up[0]; ru[u][1] = up[64];
    }
#pragma unroll
    for (int u = 0; u < 4; u++) {
      const int e = s_ei[w * 32 + u];
      const uint4* vp = (const uint4*)(V8 + (size_t)e * 2048) + lane;
      rv[u][0] = vp[0]; rv[u][1] = vp[64];
    }
  }
#pragma unroll 1
  for (int q = 0; q < 32; q += 4) {
    float hh[4];
#pragma unroll
    for (int u = 0; u < 4; u++) {
      float ha = 0.f;
#pragma unroll
      for (int c = 0; c < 2; c++) FP8_DOT(ru[u][c], c * 16, ha)
      hh[u] = ha;
    }
    const int qn = (q + 4 < 32) ? q + 4 : q;
    float gn[4];
#pragma unroll
    for (int u = 0; u < 4; u++) {
      const int e = s_ei[w * 32 + qn + u];
      gn[u] = s_ew[w * 32 + qn + u];
      const uint4* up = (const uint4*)(U8 + (size_t)e * 2048) + lane;
      ru[u][0] = up[0]; ru[u][1] = up[64];
    }
#pragma unroll
    for (int o = 32; o; o >>= 1) {
#pragma unroll
      for (int u = 0; u < 4; u++) hh[u] += __shfl_xor(hh[u], o);
    }
#pragma unroll
    for (int u = 0; u < 4; u++) {
      const float wg = gelu_tanh(hh[u] * (1.f / 1024.f)) * g[u] * (1.f / 256.f);
#pragma unroll
      for (int c = 0; c < 2; c++) FP8_AXPY(rv[u][c], c * 16, wg)
    }
#pragma unroll
    for (int u = 0; u < 4; u++) {
      const int e = s_ei[w * 32 + qn + u];
      const uint4* vp = (const uint4*)(V8 + (size_t)e * 2048) + lane;
      rv[u][0] = vp[0]; rv[u][1] = vp[64];
      g[u] = gn[u];
    }
  }
#pragma unroll
  for (int c = 0; c < 2; c++) {
    float* d = s_part + w * 2048 + c * 1024 + lane * 16;
#pragma unroll
    for (int q4 = 0; q4 < 4; q4++)
      *(float4*)(d + q4 * 4) = make_float4(acc[c * 16 + q4 * 4 + 0], acc[c * 16 + q4 * 4 + 1], acc[c * 16 + q4 * 4 + 2], acc[c * 16 + q4 * 4 + 3]);
  }
  __syncthreads();
  float x2[8] = {xa.x, xa.y, xa.z, xa.w, xb.x, xb.y, xb.z, xb.w};
#pragma unroll
  for (int ww = 0; ww < 4; ww++) {
    float4 a = *(const float4*)(s_part + ww * 2048 + t * 8), b = *(const float4*)(s_part + ww * 2048 + t * 8 + 4);
    x2[0] += a.x; x2[1] += a.y; x2[2] += a.z; x2[3] += a.w; x2[4] += b.x; x2[5] += b.y; x2[6] += b.z; x2[7] += b.w;
  }
  *(float4*)(yrow + t * 8) = make_float4(x2[0], x2[1], x2[2], x2[3]);
  *(float4*)(yrow + t * 8 + 4) = make_float4(x2[4], x2[5], x2[6], x2[7]);
  float ss2 = 0.f;
#pragma unroll
  for (int j = 0; j < 8; j++) ss2 += x2[j] * x2[j];
  ss2 = wave_sum(ss2);
  if (lane == 0) s_red[8 + w] = ss2;
  __syncthreads();
  const float rs2 = rsqrtf((s_red[8] + s_red[9] + s_red[10] + s_red[11]) * (1.f / 2048.f) + EPSF);
  {
    const float* g = p.norm_ple + t * 8;
    float f[8];
#pragma unroll
    for (int j = 0; j < 8; j++) f[j] = x2[j] * rs2 * g[j];
    *(uint4*)((bf16_t*)(p.ws + OFF_ZR) + (size_t)tok * 2048 + t * 8) = pack8(f);
    ((bf16_t*)(p.ws + OFF_PLB))[(size_t)tok * 256 + t] = f2bf(ple_row(p, tok)[t]);
  }
}
__device__ void phase_peer(CParams& p, char* smem) {
  for (int tok = blockIdx.x; tok < NTOK; tok += gridDim.x) peer_token(p, tok, smem);
}

__device__ void phase_ple(CParams& p, char* smem) {
  EPI_VARS
  const bf16_t* plb = (const bf16_t*)(p.ws + OFF_PLB);
  const bf16_t* x2n = (const bf16_t*)(p.ws + OFF_ZR);
  const bf16_t* wsw = (const bf16_t*)(p.ws + OFF_W);
  const int x = blockIdx.x & 7, per = gridDim.x >> 3;
  if ((int)blockIdx.x >= per * 8) return;
  for (int q = blockIdx.x >> 3;; q += per) {
    int mt, nt;
    if (!tile_at(q, x, 1, 16, 88, 1, mt, nt)) break;
    f32x4 acc[4][6];
    zero_acc6(acc);
    gemm_loop3(acc, plb + (size_t)mt * 192 * 256, 256, wsw + W_PLE + (size_t)nt * 128 * 256, 256, 256, smem);
    uint4* tmp = (uint4*)(p.ws + OFF_ZG) + ((size_t)(mt * 16 + nt) * 12) * 256 + opaque_u(threadIdx.x);
#pragma unroll
    for (int mm = 0; mm < 6; mm++)
#pragma unroll
      for (int n2 = 0; n2 < 2; n2++) {
        uint4 o;
        o.x = pack2(acc[2 * n2][mm][0], acc[2 * n2][mm][1]);
        o.y = pack2(acc[2 * n2][mm][2], acc[2 * n2][mm][3]);
        o.z = pack2(acc[2 * n2 + 1][mm][0], acc[2 * n2 + 1][mm][1]);
        o.w = pack2(acc[2 * n2 + 1][mm][2], acc[2 * n2 + 1][mm][3]);
        tmp[(mm * 2 + n2) * 256] = o;
      }
    zero_acc6(acc);
    gemm_loop3(acc, x2n + (size_t)mt * 192 * 2048, 2048, wsw + W_GATE + (size_t)nt * 128 * 2048, 2048, 2048, smem);
    asm volatile("" ::: "memory");
    float* yt = p.out + O_Y + (size_t)mt * 192 * 2048 + nt * 128;
    const unsigned lo = opaque_u(LROW3 * 2048 + LCOL2);
#pragma unroll
    for (int mm = 0; mm < 6; mm++)
#pragma unroll
      for (int n2 = 0; n2 < 2; n2++) {
        const uint4 a1 = tmp[(mm * 2 + n2) * 256];
#pragma unroll
        for (int h2 = 0; h2 < 2; h2++) {
          const int nn = 2 * n2 + h2;
          const unsigned alo = h2 ? a1.z : a1.x, ahi = h2 ? a1.w : a1.y;
          float4* yp = (float4*)(yt + lo + (unsigned)(mm * 16 * 2048 + nn * 16));
          float4 y = *yp;
          y.x += lo2f(alo) * sigmoidf_(acc[nn][mm][0]);
          y.y += hi2f(alo) * sigmoidf_(acc[nn][mm][1]);
          y.z += lo2f(ahi) * sigmoidf_(acc[nn][mm][2]);
          y.w += hi2f(ahi) * sigmoidf_(acc[nn][mm][3]);
          *yp = y;
        }
      }
  }
}

#define XB_TMO      128
#define XB_XCNT(j)  (256  + 64 * (j))
#define XB_XSUB(j)  (1280 + 64 * (j))
#define XB_XGEN(j)  (2304 + 64 * (j))
#define XB_TOP      3328
#define XB_TOPGEN   3392
#define XB_SPIN_CAP (1u << 22)
__device__ __forceinline__ unsigned xb_ld(unsigned* p) { return __hip_atomic_load(p, __ATOMIC_RELAXED, __HIP_MEMORY_SCOPE_AGENT); }
__device__ __forceinline__ unsigned xb_add(unsigned* p, unsigned v) { return __hip_atomic_fetch_add(p, v, __ATOMIC_RELAXED, __HIP_MEMORY_SCOPE_AGENT); }
__device__ __forceinline__ unsigned xb_xcc_id() { return (unsigned)__builtin_amdgcn_s_getreg((3 << 11) | 20) & 0xFu; }
#define XB_SPIN(cond, bar) do { unsigned _sp = 0; while (cond) { __builtin_amdgcn_s_sleep(1); \
    if ((++_sp & 255u) == 0u) { if (xb_ld(&(bar)[XB_TMO])) break; if (_sp > XB_SPIN_CAP) { atomicAdd(&(bar)[XB_TMO], 1u); break; } } } } while (0)

__device__ __forceinline__ void xcd_barrier_post(unsigned* bar) {
  if (threadIdx.x == 0) (void)xb_add(&bar[XB_XCNT(xb_xcc_id())], 1u);
}
__device__ __noinline__ void xcd_sync(unsigned* bar) {
  asm volatile("s_waitcnt vmcnt(0)" ::: "memory");
  __syncthreads();
  if (threadIdx.x == 0) {
    __builtin_amdgcn_s_waitcnt(0);
    const unsigned x = xb_xcc_id();
    unsigned packed = bar[3456 + blockIdx.x];
    unsigned nloc = packed & 0xffffu, nx = packed >> 16;
    if (nloc == 0u) {
      const unsigned G = gridDim.x;
      unsigned sum, cnt, mine, sp = 0u;
      for (;;) {
        sum = 0u; cnt = 0u; mine = 0u;
#pragma unroll
        for (unsigned j = 0; j < 16; ++j) { const unsigned c = xb_ld(&bar[XB_XCNT(j)]); sum += c; cnt += (c > 0u) ? 1u : 0u; mine = (j == x) ? c : mine; }
        if (sum == G) break;
        __builtin_amdgcn_s_sleep(1);
        if ((++sp & 255u) == 0u) { if (xb_ld(&bar[XB_TMO])) break; if (sp > XB_SPIN_CAP) { atomicAdd(&bar[XB_TMO], 1u); break; } }
      }
      nloc = mine > 0u ? mine : 1u; nx = cnt > 0u ? cnt : 1u;
      bar[3456 + blockIdx.x] = nloc | (nx << 16);
    }
    const unsigned old = xb_add(&bar[XB_XSUB(x)], 1u);
    const unsigned gen = old / nloc;
    if (old + 1u == (gen + 1u) * nloc) {
      __builtin_amdgcn_fence(__ATOMIC_RELEASE, "agent");
      asm volatile("s_waitcnt vmcnt(0)" ::: "memory");
      const unsigned og = xb_add(&bar[XB_TOP], 1u);
      const unsigned tg = og / nx;
      if (og + 1u == (tg + 1u) * nx) xb_add(&bar[XB_TOPGEN], 1u);
      else XB_SPIN(xb_ld(&bar[XB_TOPGEN]) == tg, bar);
      __builtin_amdgcn_fence(__ATOMIC_ACQUIRE, "agent");
      xb_add(&bar[XB_XGEN(x)], 1u);
      asm volatile("s_waitcnt vmcnt(0)" ::: "memory");
    } else {
      XB_SPIN(xb_ld(&bar[XB_XGEN(x)]) == gen, bar);
      __builtin_amdgcn_fence(__ATOMIC_ACQUIRE, "agent");
      asm volatile("s_waitcnt vmcnt(0)" ::: "memory");
    }
  }
  __syncthreads();
}

__global__ void __launch_bounds__(256, 2) mega_kernel(Params p_unused) {
  __shared__ __attribute__((aligned(16))) char smem[81920];
  xcd_barrier_post((unsigned*)(get_params()->ws + OFF_BAR));
  { CParams& p = *get_params(); phase_prep(p, smem); }
  xcd_sync((unsigned*)(get_params()->ws + OFF_BAR));
  { CParams& p = *get_params(); phase_gemm1(p, smem); }
  xcd_sync((unsigned*)(get_params()->ws + OFF_BAR));
  { CParams& p = *get_params(); phase_mix(p, smem); }
  xcd_sync((unsigned*)(get_params()->ws + OFF_BAR));
  { CParams& p = *get_params(); phase_scan2(p); }
  xcd_sync((unsigned*)(get_params()->ws + OFF_BAR));
  { CParams& p = *get_params(); phase_proj(p, smem); }
  xcd_sync((unsigned*)(get_params()->ws + OFF_BAR));
  { CParams& p = *get_params(); phase_wout(p, smem); }
  xcd_sync((unsigned*)(get_params()->ws + OFF_BAR));
  { CParams& p = *get_params(); phase_pq(p, smem); }
  xcd_sync((unsigned*)(get_params()->ws + OFF_BAR));
  { CParams& p = *get_params(); phase_peer(p, smem); }
  xcd_sync((unsigned*)(get_params()->ws + OFF_BAR));
  { CParams& p = *get_params(); phase_ple(p, smem); }
  if (get_params()->ws == nullptr) cg::this_grid().sync();
}

extern "C" void kernel_launch(void* const* d_in, const int* in_sizes, int n_in, void* d_out, int out_size, void* d_ws,
                              size_t ws_size, hipStream_t stream) {
  static int grid_blocks = 0;
  if (!grid_blocks) {
    int dev = 0, cus = 0, per_cu = 0;
    hipGetDevice(&dev);
    hipDeviceGetAttribute(&cus, hipDeviceAttributeMultiprocessorCount, dev);
    hipOccupancyMaxActiveBlocksPerMultiprocessor(&per_cu, mega_kernel, 256, 0);
    if (per_cu > 2) per_cu = 2;
    grid_blocks = cus * per_cu;
    if (ws_size < WS_NEED) fprintf(stderr, "workspace too small: %zu < %zu\n", ws_size, (size_t)WS_NEED);
  }
  Params p{};
  const float** pp = (const float**)&p;
  for (int i = 0; i < 31; i++) pp[i] = (const float*)d_in[i];
  p.out = (float*)d_out;
  p.ws = (char*)d_ws;
  hipMemsetAsync((char*)d_ws + OFF_BAR, 0, 16384, stream);
  void* args[] = {&p};
  hipError_t e = hipLaunchCooperativeKernel((void*)mega_kernel, dim3(grid_blocks), dim3(256), args, 0, stream);
  if (e != hipSuccess) fprintf(stderr, "cooperative launch failed: %s (grid %d)\n", hipGetErrorString(e), grid_blocks);
}
```

```cpp
#include <hip/hip_runtime.h>
#include <hip/hip_cooperative_groups.h>
#include <stdint.h>
#include <cstdio>
namespace cg = cooperative_groups;

#ifndef MEGA
#define MEGA 1
#endif

typedef unsigned short bf16_t;
using bf16x8 = __attribute__((ext_vector_type(8))) short;
using f32x16 = __attribute__((ext_vector_type(16))) float;
using u32x8 = __attribute__((ext_vector_type(8))) unsigned;
using u32x2 = __attribute__((ext_vector_type(2))) unsigned;

#define NTOK 16896
#define NPROMPT 16384
#define EPSF 1e-6f

#define OFF_R1   ((size_t)0)
#define OFF_ZR   (OFF_R1 + (size_t)69206016)
#define OFF_ZG   (OFF_ZR + (size_t)121110528)
#define OFF_W    (OFF_ZG + (size_t)138412032)
#define OFF_U    (OFF_W + (size_t)67108864)
#define OFF_V    (OFF_U + (size_t)33554432)
#define OFF_SUM  (OFF_V + (size_t)33554432)
#define OFF_ROPE (OFF_SUM + (size_t)4194304)
#define OFF_PLB  (OFF_ROPE + (size_t)262400)
#define OFF_BAR  (OFF_PLB + (size_t)8650752)
#define WS_NEED  (OFF_BAR + (size_t)16384)

#define W_IN   ((size_t)0)
#define W_RNN  (W_IN + (size_t)7680 * 2048)
#define W_ATT  (W_RNN + (size_t)2048 * 1024)
#define W_OUT  (W_ATT + (size_t)2048 * 1024)
#define W_PQ   (W_OUT + (size_t)2048 * 2048)
#define W_PLE  (W_PQ + (size_t)2048 * 2048)
#define W_GATE (W_PLE + (size_t)2048 * 256)
#define W_RG   (W_GATE + (size_t)2048 * 2048)
#define W_IG   (W_RG + (size_t)8 * 128 * 128)
#define W_SK   (W_IG + (size_t)8 * 128 * 128)

#define O_Y      ((size_t)0)
#define O_PCONV  ((size_t)34603008)
#define O_PRG    ((size_t)34615296)
#define O_PK     ((size_t)34619392)
#define O_PV     ((size_t)34750464)
#define O_SCONV  ((size_t)34881536)
#define O_SRG    ((size_t)35274752)
#define O_SK     ((size_t)35405824)
#define O_SV     ((size_t)39600128)

struct Params {
  const float *x_prompt, *x_sample, *p_prompt, *p_sample, *state_conv, *state_rglru, *cache_k, *cache_v;
  const float *norm_mix, *w_in, *conv_w, *conv_b, *w_rgate, *b_rgate, *w_igate, *b_igate, *lru_lambda, *w_proj_rnn;
  const float *q_norm, *k_norm, *attn_sinks, *w_proj_attn, *w_out, *norm_ffn, *w_peer_q, *sub_keys, *peer_u, *peer_v;
  const float *w_ple, *norm_ple, *w_ple_gate;
  float* out;
  char* ws;
};

typedef const __attribute__((address_space(4))) Params CParams;
__device__ __forceinline__ CParams* get_params() {
  CParams* kp = (CParams*)__builtin_amdgcn_kernarg_segment_ptr();
  asm volatile("" : "+s"(kp));
  return kp;
}
__device__ __forceinline__ bf16_t f2bf(float f) {
  unsigned u = __float_as_uint(f);
  u += 0x7fffu + ((u >> 16) & 1u);
  return (bf16_t)(u >> 16);
}
__device__ __forceinline__ float bf2f(bf16_t b) { return __uint_as_float(((unsigned)b) << 16); }
__device__ __forceinline__ unsigned pack2(float a, float b) { return (unsigned)f2bf(a) | ((unsigned)f2bf(b) << 16); }
__device__ __forceinline__ float lo2f(unsigned d) { return __uint_as_float(d << 16); }
__device__ __forceinline__ float hi2f(unsigned d) { return __uint_as_float(d & 0xffff0000u); }
__device__ __forceinline__ float sigmoidf_(float x) { return __builtin_amdgcn_rcpf(1.f + __expf(-x)); }
__device__ __forceinline__ float gelu_tanh(float x) {
  float y = 0.7978845608028654f * (x + 0.044715f * x * x * x);
  float th = 1.f - 2.f * __builtin_amdgcn_rcpf(1.f + __expf(2.f * y));
  return 0.5f * x * (1.f + th);
}
__device__ __forceinline__ float wave_sum(float v) {
#pragma unroll
  for (int o = 32; o; o >>= 1) v += __shfl_xor(v, o);
  return v;
}
__device__ __forceinline__ float wave_max(float v) {
#pragma unroll
  for (int o = 32; o; o >>= 1) v = fmaxf(v, __shfl_xor(v, o));
  return v;
}
__device__ __forceinline__ void unpack8(const uint4& u, float* f) {
  f[0] = lo2f(u.x); f[1] = hi2f(u.x); f[2] = lo2f(u.y); f[3] = hi2f(u.y);
  f[4] = lo2f(u.z); f[5] = hi2f(u.z); f[6] = lo2f(u.w); f[7] = hi2f(u.w);
}
__device__ __forceinline__ uint4 pack8(const float* f) {
  uint4 u; u.x = pack2(f[0], f[1]); u.y = pack2(f[2], f[3]); u.z = pack2(f[4], f[5]); u.w = pack2(f[6], f[7]);
  return u;
}
__device__ __forceinline__ const float* x_row(CParams& p, int tok) {
  return tok < NPROMPT ? p.x_prompt + (size_t)tok * 2048 : p.x_sample + (size_t)(tok - NPROMPT) * 2048;
}
__device__ __forceinline__ const float* ple_row(CParams& p, int tok) {
  return tok < NPROMPT ? p.p_prompt + (size_t)tok * 256 : p.p_sample + (size_t)(tok - NPROMPT) * 256;
}

__device__ __forceinline__ bool tile_at(int q, int x, int SM, int SN, int NSM, int NSN, int& mt, int& nt) {
  int ST = SM * SN;
  int sup = (q / ST) * 8 + x;
  if (sup >= NSM * NSN) return false;
  int wi = q % ST;
  mt = (sup / NSN) * SM + wi / SN;
  nt = (sup % NSN) * SN + wi % SN;
  return true;
}

using f32x4 = __attribute__((ext_vector_type(4))) float;
__device__ __forceinline__ void stage_rc(int b, int& R, int& C) {
  int st = b >> 10, sb = b & 1023, swz = sb ^ (((sb >> 9) & 1) << 5);
  R = (st >> 1) * 16 + (swz >> 6);
  C = (st & 1) * 32 + ((swz & 63) >> 1);
}
__device__ __forceinline__ void gemm_loop(f32x4 (&acc)[4][4], const bf16_t* __restrict__ A, int lda,
                                          const bf16_t* __restrict__ B, int ldb, int K, char* smem) {
  const int t = threadIdx.x, lane = t & 63, w = t >> 6, wm = w >> 1, wn = w & 1;
  const int fr = lane & 15, fq = lane >> 4;
  unsigned aoff[4], boff[4];
#pragma unroll
  for (int i = 0; i < 4; i++) {
    int R, C;
    stage_rc(t * 16 + i * 4096, R, C);
    aoff[i] = R * lda + C;
    boff[i] = R * ldb + C;
  }
#define GL_STAGE(s, ko)                                                                                             \
  _Pragma("unroll") for (int i_ = 0; i_ < 4; i_++) {                                                                \
    __builtin_amdgcn_global_load_lds((const unsigned*)(A + aoff[i_] + (ko)),                                        \
                                     (unsigned*)(smem + (s) * 32768 + t * 16 + i_ * 4096), 16, 0, 0);               \
    __builtin_amdgcn_global_load_lds((const unsigned*)(B + boff[i_] + (ko)),                                        \
                                     (unsigned*)(smem + (s) * 32768 + 16384 + t * 16 + i_ * 4096), 16, 0, 0);       \
  }
  const int lane_off = ((fr * 64 + fq * 16) ^ ((fr >> 3) << 5));
  const int a_base = wm * 8192 + lane_off, b_base = 16384 + wn * 8192 + lane_off;
  __syncthreads();
  GL_STAGE(0, 0)
  const int nt = K >> 6;
  for (int kt = 0; kt < nt; kt++) {
    const int cur = kt & 1;
    __syncthreads();
    if (kt + 1 < nt) { GL_STAGE(cur ^ 1, (kt + 1) * 64) }
    const char* sb = smem + cur * 32768;
#pragma unroll
    for (int k2 = 0; k2 < 2; k2++) {
      bf16x8 af[4], bfr[4];
#pragma unroll
      for (int m = 0; m < 4; m++) af[m] = *(const bf16x8*)(sb + a_base + m * 2048 + k2 * 1024);
#pragma unroll
      for (int n = 0; n < 4; n++) bfr[n] = *(const bf16x8*)(sb + b_base + n * 2048 + k2 * 1024);
#pragma unroll
      for (int n = 0; n < 4; n++)
#pragma unroll
        for (int m = 0; m < 4; m++) acc[n][m] = __builtin_amdgcn_mfma_f32_16x16x32_bf16(bfr[n], af[m], acc[n][m], 0, 0, 0);
    }
  }
}
__device__ __forceinline__ void zero_acc4(f32x4 (&acc)[4][4]) {
#pragma unroll
  for (int i = 0; i < 4; i++)
#pragma unroll
    for (int j = 0; j < 4; j++) acc[i][j] = (f32x4){0.f, 0.f, 0.f, 0.f};
}
#define LROW2 (wm * 64 + (lane & 15))
#define LCOL2 (wn * 64 + (lane >> 4) * 4)

#define G3_STAGE_BYTES 40960
#define G3_B_OFF 24576
__device__ __forceinline__ void gemm_loop3(f32x4 (&acc)[4][6], const bf16_t* __restrict__ A, int lda,
                                           const bf16_t* __restrict__ B, int ldb, int K, char* smem) {
  const int t = threadIdx.x, lane = t & 63, w = t >> 6, wm = w >> 1, wn = w & 1;
  const int fr = lane & 15, fq = lane >> 4;
  unsigned aoff[6], boff[4];
#pragma unroll
  for (int i = 0; i < 6; i++) {
    int R, C;
    stage_rc(t * 16 + i * 4096, R, C);
    aoff[i] = R * lda + C;
    if (i < 4) boff[i] = R * ldb + C;
  }
#define G3_ISSUE(s, ko)                                                                                        \
  {                                                                                                            \
    char* sb_ = smem + (s) * G3_STAGE_BYTES + t * 16;                                                          \
    _Pragma("unroll") for (int i_ = 0; i_ < 6; i_++)                                                           \
        __builtin_amdgcn_global_load_lds((const unsigned*)(A + (unsigned)(aoff[i_] + (ko))), (unsigned*)(sb_ + i_ * 4096), 16, 0, 0); \
    _Pragma("unroll") for (int i_ = 0; i_ < 4; i_++)                                                           \
        __builtin_amdgcn_global_load_lds((const unsigned*)(B + (unsigned)(boff[i_] + (ko))), (unsigned*)(sb_ + G3_B_OFF + i_ * 4096), 16, 0, 0); \
  }
  const int lane_off = ((fr * 64 + fq * 16) ^ ((fr >> 3) << 5));
  const int a_base = wm * 12288 + lane_off, b_base = G3_B_OFF + wn * 8192 + lane_off;
  __syncthreads();
  const int nt = K >> 6;
  G3_ISSUE(0, 0)
  for (int kt = 0; kt < nt; kt++) {
    const int cur = kt & 1;
    __syncthreads();
    if (kt + 1 < nt) G3_ISSUE(cur ^ 1, (kt + 1) * 64)
    const char* sb = smem + cur * G3_STAGE_BYTES;
#pragma unroll
    for (int k2 = 0; k2 < 2; k2++) {
      bf16x8 af[6], bfr[4];
#pragma unroll
      for (int m = 0; m < 6; m++) af[m] = *(const bf16x8*)(sb + a_base + m * 2048 + k2 * 1024);
#pragma unroll
      for (int n = 0; n < 4; n++) bfr[n] = *(const bf16x8*)(sb + b_base + n * 2048 + k2 * 1024);
#pragma unroll
      for (int n = 0; n < 4; n++)
#pragma unroll
        for (int m = 0; m < 6; m++) acc[n][m] = __builtin_amdgcn_mfma_f32_16x16x32_bf16(bfr[n], af[m], acc[n][m], 0, 0, 0);
      __builtin_amdgcn_sched_barrier(0);
    }
  }
}
__device__ __forceinline__ void zero_acc6(f32x4 (&acc)[4][6]) {
#pragma unroll
  for (int i = 0; i < 4; i++)
#pragma unroll
    for (int j = 0; j < 6; j++) acc[i][j] = (f32x4){0.f, 0.f, 0.f, 0.f};
}
#define LROW3 (wm * 96 + (lane & 15))

__device__ __forceinline__ void lds_gemm128(f32x16 (&acc)[2][2], const bf16_t (*A2)[136], const bf16_t (*B2)[136]) {
  const int t = threadIdx.x, lane = t & 63, w = t >> 6, wm = w >> 1, wn = w & 1;
  const int fr = lane & 31, fk = (lane >> 5) * 8;
#pragma unroll
  for (int kk = 0; kk < 8; kk++) {
    bf16x8 a0 = *(const bf16x8*)&A2[wm * 64 + fr][kk * 16 + fk];
    bf16x8 a1 = *(const bf16x8*)&A2[wm * 64 + 32 + fr][kk * 16 + fk];
    bf16x8 b0 = *(const bf16x8*)&B2[wn * 64 + fr][kk * 16 + fk];
    bf16x8 b1 = *(const bf16x8*)&B2[wn * 64 + 32 + fr][kk * 16 + fk];
    acc[0][0] = __builtin_amdgcn_mfma_f32_32x32x16_bf16(a0, b0, acc[0][0], 0, 0, 0);
    acc[0][1] = __builtin_amdgcn_mfma_f32_32x32x16_bf16(a0, b1, acc[0][1], 0, 0, 0);
    acc[1][0] = __builtin_amdgcn_mfma_f32_32x32x16_bf16(a1, b0, acc[1][0], 0, 0, 0);
    acc[1][1] = __builtin_amdgcn_mfma_f32_32x32x16_bf16(a1, b1, acc[1][1], 0, 0, 0);
  }
}
__device__ __forceinline__ void load_b2(bf16_t (*B2)[136], const bf16_t* __restrict__ src) {
  const int t = threadIdx.x;
#pragma unroll
  for (int i = 0; i < 8; i++) {
    int c = t + 256 * i, row = c >> 4, col = (c & 15) * 8;
    *(uint4*)&B2[row][col] = *(const uint4*)(src + row * 128 + col);
  }
}
__device__ __forceinline__ void zero_acc(f32x16 (&acc)[2][2]) {
#pragma unroll
  for (int i = 0; i < 2; i++)
#pragma unroll
    for (int j = 0; j < 2; j++)
#pragma unroll
      for (int r = 0; r < 16; r++) acc[i][j][r] = 0.f;
}
#define ACC_ROW(i, r) (wm * 64 + (i) * 32 + ((r) & 3) + 8 * ((r) >> 2) + 4 * (lane >> 5))
#define ACC_COL(j) (wn * 64 + (j) * 32 + (lane & 31))
#define EPI_VARS const int lane = threadIdx.x & 63, wm = threadIdx.x >> 7, wn = (threadIdx.x >> 6) & 1;
#define ROWC(i, r) ((i) * 32 + ((r) & 3) + 8 * ((r) >> 2))
#define LROW (wm * 64 + 4 * (lane >> 5))
#define LCOL (wn * 64 + (lane & 31))
__device__ __forceinline__ unsigned opaque_u(unsigned v) { asm volatile("" : "+v"(v)); return v; }

typedef float nt_f4 __attribute__((ext_vector_type(4)));
__device__ __forceinline__ float4 ld_nt4(const float* p) { nt_f4 v = __builtin_nontemporal_load((const nt_f4*)p); return make_float4(v.x, v.y, v.z, v.w); }
__device__ void transpose_tile(const float* __restrict__ src, int ld_src, bf16_t* __restrict__ dst, int ld_dst,
                               int k0, int n0, const float* __restrict__ kscale, char* smem) {
  float (*tile)[65] = (float (*)[65])smem;
  const int t = threadIdx.x;
  __syncthreads();
  const int n4 = (t & 15) * 4, kr = t >> 4;
#pragma unroll
  for (int i = 0; i < 4; i++) {
    int k = kr + 16 * i;
    float4 v = ld_nt4(src + (size_t)(k0 + k) * ld_src + n0 + n4);
    float s = kscale ? kscale[k0 + k] : 1.f;
    tile[k][n4 + 0] = v.x * s; tile[k][n4 + 1] = v.y * s; tile[k][n4 + 2] = v.z * s; tile[k][n4 + 3] = v.w * s;
  }
  __syncthreads();
  const int n = t >> 2, ks = (t & 3) * 16;
  float f[16];
#pragma unroll
  for (int j = 0; j < 16; j++) f[j] = tile[ks + j][n];
  uint4* d = (uint4*)(dst + (size_t)(n0 + n) * ld_dst + k0 + ks);
  d[0] = pack8(f); d[1] = pack8(f + 8);
}

__device__ void phase_prep(CParams& p, char* smem) {
  const int t = threadIdx.x, lane = t & 63, w = t >> 6;
  bf16_t* wsw = (bf16_t*)(p.ws + OFF_W);
  const int N_RMS = NTOK / 4, N_TR = 8128, N_SK = 128, N_UV = 32768, N_ROPE = 129;
  const int TOTAL = N_RMS + N_TR + N_SK + N_UV + N_ROPE;
  for (int it = blockIdx.x; it < TOTAL; it += gridDim.x) {
    int i = it;
    if (i < N_UV) {
      const bool isu = i < 16384;
      const float* src = isu ? p.peer_u + (size_t)i * 2048 : p.peer_v + (size_t)(i - 16384) * 2048;
      unsigned char* dst = (unsigned char*)(p.ws + (isu ? OFF_U : OFF_V)) + (size_t)(i & 16383) * 2048;
      const float sc = isu ? 1024.f : 256.f;
      float4 a = ld_nt4(src + t * 8), b = ld_nt4(src + t * 8 + 4);
      int w0 = __builtin_amdgcn_cvt_pk_fp8_f32(a.x * sc, a.y * sc, 0, false);
      w0 = __builtin_amdgcn_cvt_pk_fp8_f32(a.z * sc, a.w * sc, w0, true);
      int w1 = __builtin_amdgcn_cvt_pk_fp8_f32(b.x * sc, b.y * sc, 0, false);
      w1 = __builtin_amdgcn_cvt_pk_fp8_f32(b.z * sc, b.w * sc, w1, true);
      *(uint2*)(dst + t * 8) = make_uint2((unsigned)w0, (unsigned)w1);
      continue;
    }
    i -= N_UV;
    if (i < N_RMS) {
      int tok = i * 4 + w;
      const float* xr = x_row(p, tok);
      float v[32]; float ss = 0.f;
#pragma unroll
      for (int c = 0; c < 4; c++) {
        float4 a = ld_nt4(xr + c * 512 + lane * 8), b = ld_nt4(xr + c * 512 + lane * 8 + 4);
        v[c * 8 + 0] = a.x; v[c * 8 + 1] = a.y; v[c * 8 + 2] = a.z; v[c * 8 + 3] = a.w;
        v[c * 8 + 4] = b.x; v[c * 8 + 5] = b.y; v[c * 8 + 6] = b.z; v[c * 8 + 7] = b.w;
      }
#pragma unroll
      for (int j = 0; j < 32; j++) ss += v[j] * v[j];
      ss = wave_sum(ss);
      float rs = rsqrtf(ss * (1.f / 2048.f) + EPSF);
      bf16_t* dst = (bf16_t*)(p.ws + OFF_R1) + (size_t)tok * 2048;
#pragma unroll
      for (int c = 0; c < 4; c++) {
        const float* g = p.norm_mix + c * 512 + lane * 8;
        float f[8];
#pragma unroll
        for (int j = 0; j < 8; j++) f[j] = v[c * 8 + j] * rs * g[j];
        *(uint4*)(dst + c * 512 + lane * 8) = pack8(f);
      }
      continue;
    }
    i -= N_RMS;
    if (i < N_TR) {
      const float* src; bf16_t* dst; int K, Nn; const float* ks = nullptr;
      if (i < 3840) { src = p.w_in; dst = wsw + W_IN; K = 2048; Nn = 7680; }
      else if ((i -= 3840) < 512) { src = p.w_proj_rnn; dst = wsw + W_RNN; K = 1024; Nn = 2048; }
      else if ((i -= 512) < 512) { src = p.w_proj_attn; dst = wsw + W_ATT; K = 1024; Nn = 2048; }
      else if ((i -= 512) < 1024) { src = p.w_out; dst = wsw + W_OUT; K = 2048; Nn = 2048; }
      else if ((i -= 1024) < 1024) { src = p.w_peer_q; dst = wsw + W_PQ; K = 2048; Nn = 2048; ks = p.norm_ffn; }
      else if ((i -= 1024) < 128) { src = p.w_ple; dst = wsw + W_PLE; K = 256; Nn = 2048; }
      else if ((i -= 128) < 1024) { src = p.w_ple_gate; dst = wsw + W_GATE; K = 2048; Nn = 2048; }
      else if ((i -= 1024) < 32) { int b = i >> 2; src = p.w_rgate + b * 16384; dst = wsw + W_RG + b * 16384; K = 128; Nn = 128; i &= 3; }
      else { i -= 32; int b = i >> 2; src = p.w_igate + b * 16384; dst = wsw + W_IG + b * 16384; K = 128; Nn = 128; i &= 3; }
      int nkt = K / 64;
      int kt = i % nkt, ntile = i / nkt;
      transpose_tile(src, Nn, dst, K, kt * 64, ntile * 64, ks, smem);
      continue;
    }
    i -= N_TR;
    if (i < N_SK) {
      const float* src = p.sub_keys + (size_t)i * 2048;
      bf16_t* dst = wsw + W_SK + (size_t)i * 2048;
      float4 a = ld_nt4(src + t * 8), b = ld_nt4(src + t * 8 + 4);
      uint4 o; o.x = pack2(a.x, a.y); o.y = pack2(a.z, a.w); o.z = pack2(b.x, b.y); o.w = pack2(b.z, b.w);
      *(uint4*)(dst + t * 8) = o;
      continue;
    }
    i -= N_SK;
    {
      int e = i * 256 + t;
      if (e < 4100 * 8) {
        int pi = e >> 3, fi = e & 7;
        int pos = pi < 4096 ? pi : 16384 + (pi - 4096);
        float inv = powf(500000.f, -(float)fi * 0.125f);
        float ang = (float)pos * inv;
        double tr = (double)ang * 0.15915494309189535;
        tr -= rint(tr);
        float fr = (float)tr;
        float2 cs; cs.x = __builtin_amdgcn_cosf(fr); cs.y = __builtin_amdgcn_sinf(fr);
        ((float2*)(p.ws + OFF_ROPE))[e] = cs;
      }
    }
  }
}

__device__ void phase_gemm1(CParams& p, char* smem) {
  EPI_VARS
  const bf16_t* A = (const bf16_t*)(p.ws + OFF_R1);
  const bf16_t* B = (const bf16_t*)(p.ws + OFF_W) + W_IN;
  bf16_t* zr = (bf16_t*)(p.ws + OFF_ZR);
  bf16_t* zg = (bf16_t*)(p.ws + OFF_ZG);
  const int x = blockIdx.x & 7, per = gridDim.x >> 3;
  if ((int)blockIdx.x >= per * 8) return;
  for (int q = blockIdx.x >> 3;; q += per) {
    int mt, nt;
    if (!tile_at(q, x, 4, 10, 22, 6, mt, nt)) break;
    f32x4 acc[4][6];
    zero_acc6(acc);
    gemm_loop3(acc, A + (size_t)mt * 192 * 2048, 2048, B + (size_t)nt * 128 * 2048, 2048, 2048, smem);
    const int n0 = nt * 128;
    const int act = (n0 < 1024) ? 0 : (n0 < 2048 ? 1 : (n0 < 3584 ? 0 : 2));
    bf16_t* dst; int ld, cb;
    if (n0 < 3584) { dst = zr; ld = 3584; cb = n0; } else { dst = zg; ld = 4096; cb = n0 - 3584; }
    if (act == 2) {
      uint4* gt = (uint4*)zg + ((size_t)(mt * 32 + (nt - 28)) * 12) * 256 + opaque_u(threadIdx.x);
#pragma unroll
      for (int mm = 0; mm < 6; mm++)
#pragma unroll
        for (int n2 = 0; n2 < 2; n2++) {
          uint4 o;
          o.x = pack2(sigmoidf_(acc[2 * n2][mm][0]), sigmoidf_(acc[2 * n2][mm][1]));
          o.y = pack2(sigmoidf_(acc[2 * n2][mm][2]), sigmoidf_(acc[2 * n2][mm][3]));
          o.z = pack2(sigmoidf_(acc[2 * n2 + 1][mm][0]), sigmoidf_(acc[2 * n2 + 1][mm][1]));
          o.w = pack2(sigmoidf_(acc[2 * n2 + 1][mm][2]), sigmoidf_(acc[2 * n2 + 1][mm][3]));
          gt[(mm * 2 + n2) * 256] = o;
        }
    } else {
      bf16_t* dt = dst + (size_t)mt * 192 * ld + cb;
      bf16_t (*T)[136] = (bf16_t (*)[136])smem;
      __syncthreads();
      const unsigned lrow = opaque_u(LROW3), lcol = opaque_u(LCOL2);
#pragma unroll
      for (int mm = 0; mm < 6; mm++)
#pragma unroll
        for (int nn = 0; nn < 4; nn++) {
          float v[4];
#pragma unroll
          for (int j = 0; j < 4; j++) {
            v[j] = acc[nn][mm][j];
            if (act == 1) v[j] = gelu_tanh(v[j]);
          }
          *(uint2*)&T[lrow + mm * 16][lcol + nn * 16] = make_uint2(pack2(v[0], v[1]), pack2(v[2], v[3]));
        }
      __syncthreads();
      const unsigned tt = opaque_u(threadIdx.x);
#pragma unroll
      for (int i = 0; i < 12; i++) {
        const unsigned c = tt + 256u * i, row = c >> 4, ch = (c & 15u) * 8u;
        *(uint4*)(dt + (size_t)row * ld + ch) = *(const uint4*)&T[row][ch];
      }
    }
  }
}

__device__ void rglru_tile(CParams& p, int mt, int jb, char* smem) {
  EPI_VARS
  bf16_t (*A2)[136] = (bf16_t (*)[136])smem;
  bf16_t (*B2)[136] = (bf16_t (*)[136])(smem + 34816);
  const bf16_t* zr = (const bf16_t*)(p.ws + OFF_ZR);
  const bf16_t* wsw = (const bf16_t*)(p.ws + OFF_W);
  unsigned* ab_arr = (unsigned*)p.out;
  const int t = threadIdx.x;
  const int c8 = (t & 15) * 8, r0 = t >> 4, ch0 = jb * 128 + c8;
  float cw[4][8], cbias[8];
#pragma unroll
  for (int k = 0; k < 4; k++)
#pragma unroll
    for (int j = 0; j < 8; j++) cw[k][j] = p.conv_w[k * 1024 + ch0 + j];
#pragma unroll
  for (int j = 0; j < 8; j++) cbias[j] = p.conv_b[ch0 + j];
  __syncthreads();
  for (int i = 0; i < 8; i++) {
    int r = r0 + 16 * i, tok = mt * 128 + r;
    float xc[8];
#pragma unroll
    for (int j = 0; j < 8; j++) xc[j] = cbias[j];
#pragma unroll
    for (int d = 0; d < 4; d++) {
      float xv[8];
      bool fromz, zero = false;
      int sidx = 0;
      if (tok < NPROMPT) { fromz = ((tok & 4095) >= d); zero = !fromz; }
      else { int s = tok - NPROMPT, dt = s & 3; fromz = (dt >= d); sidx = ((s >> 2) * 3 + (3 + dt - d)); }
      if (fromz) {
        uint4 u = *(const uint4*)(zr + (size_t)(tok - d) * 3584 + ch0);
        unpack8(u, xv);
      } else if (zero) {
#pragma unroll
        for (int j = 0; j < 8; j++) xv[j] = 0.f;
      } else {
        const float* sp = p.state_conv + (size_t)sidx * 1024 + ch0;
#pragma unroll
        for (int j = 0; j < 8; j++) xv[j] = sp[j];
      }
      if (d == 0) {
        if (tok < NPROMPT) {
          int ts = tok & 4095;
          if (ts >= 4093) {
            float* o = p.out + O_PCONV + (size_t)((tok >> 12) * 3 + (ts - 4093)) * 1024 + ch0;
#pragma unroll
            for (int j = 0; j < 8; j++) o[j] = xv[j];
          }
        } else {
          int s = tok - NPROMPT, dt = s & 3;
          if (dt >= 1) {
            float* o = p.out + O_SCONV + (size_t)((s >> 2) * 3 + (dt - 1)) * 1024 + ch0;
#pragma unroll
            for (int j = 0; j < 8; j++) o[j] = xv[j];
          }
        }
      }
#pragma unroll
      for (int j = 0; j < 8; j++) xc[j] += cw[3 - d][j] * xv[j];
    }
    *(uint4*)&A2[r][c8] = pack8(xc);
  }
  load_b2(B2, wsw + W_RG + jb * 16384);
  __syncthreads();
  f32x16 accr[2][2], acci[2][2];
  zero_acc(accr); zero_acc(acci);
  lds_gemm128(accr, A2, B2);
  __syncthreads();
  load_b2(B2, wsw + W_IG + jb * 16384);
  __syncthreads();
  lds_gemm128(acci, A2, B2);
  float* sumP = (float*)(p.ws + OFF_SUM);
  float* sumH = sumP + 524288;
  const int hh = lane >> 5;
#pragma unroll
  for (int j = 0; j < 2; j++) {
    int col = ACC_COL(j), ch = jb * 128 + col;
    float br = p.b_rgate[ch], bi = p.b_igate[ch];
    float sp = log1pf(__expf(-p.lru_lambda[ch]));
#pragma unroll
    for (int i = 0; i < 2; i++) {
      float Pq[4], Hq[4];
#pragma unroll
      for (int r = 0; r < 16; r++) {
        int row = ACC_ROW(i, r), tok = mt * 128 + row;
        float xcv = bf2f(A2[row][col]);
        float rg = __builtin_amdgcn_rcpf(1.f + __expf(-(accr[i][j][r] + br)));
        float ig = __builtin_amdgcn_rcpf(1.f + __expf(-(acci[i][j][r] + bi)));
        float la = -8.f * rg * sp;
        float a = __expf(la);
        float mult = (tok < NPROMPT && (tok & 4095) == 0) ? 1.f : sqrtf(fmaxf(1.f - a * a, 0.f));
        float bv = mult * ig * xcv;
        const unsigned da = f2bf(1.f - a), bb = f2bf(bv);
        ab_arr[(size_t)tok * 1024 + ch] = (da << 16) | bb;
        const float ar = 1.f - bf2f((bf16_t)da), brr = bf2f((bf16_t)bb);
        if ((r & 3) == 0) { Pq[r >> 2] = ar; Hq[r >> 2] = brr; }
        else { Pq[r >> 2] *= ar; Hq[r >> 2] = Hq[r >> 2] * ar + brr; }
      }
      if (mt < 128) {
        float P = 1.f, H = 0.f;
#pragma unroll
        for (int q = 0; q < 4; q++) {
          float Pp = __shfl_xor(Pq[q], 32), Hp = __shfl_xor(Hq[q], 32);
          float P1 = hh ? Pp : Pq[q], H1 = hh ? Hp : Hq[q];
          float P2 = hh ? Pq[q] : Pp, H2 = hh ? Hq[q] : Hp;
          H = H * P1 + H1; P *= P1;
          H = H * P2 + H2; P *= P2;
        }
        if (hh == 0) {
          int cid = mt * 4 + wm * 2 + i;
          sumP[(size_t)cid * 1024 + ch] = P;
          sumH[(size_t)cid * 1024 + ch] = H;
        }
      }
    }
  }
}

__device__ void attn_prompt_item(CParams& p, int b, int nb, int kvh, char* smem) {
  const int t = threadIdx.x, lane = t & 63, w = t >> 6;
  bf16_t (*Ks)[72] = (bf16_t (*)[72])smem;
  bf16_t (*Vt)[264] = (bf16_t (*)[264])(smem + 36864);
  const bf16_t* zr = (const bf16_t*)(p.ws + OFF_ZR);
  const float2* rope = (const float2*)(p.ws + OFF_ROPE);
  bf16_t* obuf = (bf16_t*)(p.ws + OFF_R1) + (size_t)NTOK * 1024;
  __syncthreads();
  {
    int jk = t;
    int ts = (nb - 1) * 128 + jk;
    if (ts >= 0) {
      int tok = b * 4096 + ts;
      const bf16_t* kp = zr + (size_t)tok * 3584 + 3072 + kvh * 64;
      const bf16_t* vp = zr + (size_t)tok * 3584 + 3328 + kvh * 64;
      const bool wout = (nb == 31 && jk >= 128);
      float* ok = p.out + O_PK + (size_t)((b * 128 + (jk - 128)) * 4 + kvh) * 64;
      float* ov = p.out + O_PV + (size_t)((b * 128 + (jk - 128)) * 4 + kvh) * 64;
      uint4 k0 = *(const uint4*)(kp), k1 = *(const uint4*)(kp + 8), k2 = *(const uint4*)(kp + 16), k3 = *(const uint4*)(kp + 24);
      uint4 k4 = *(const uint4*)(kp + 32), k5 = *(const uint4*)(kp + 40), k6 = *(const uint4*)(kp + 48), k7 = *(const uint4*)(kp + 56);
      float ss = 0.f;
#define SSQ8(u) { float f_[8]; unpack8(u, f_); for (int j_ = 0; j_ < 8; j_++) ss += f_[j_] * f_[j_]; }
      SSQ8(k0) SSQ8(k1) SSQ8(k2) SSQ8(k3) SSQ8(k4) SSQ8(k5) SSQ8(k6) SSQ8(k7)
      const float rs = rsqrtf(ss * (1.f / 64.f) + EPSF);
      {
        float f0[8], f1[8];
        unpack8(k0, f0); unpack8(k1, f1);
#pragma unroll
        for (int i = 0; i < 8; i++) {
          float x1 = f0[i] * rs * p.k_norm[i], x2 = f1[i] * rs * p.k_norm[8 + i];
          float2 cs = rope[ts * 8 + i];
          f0[i] = x1 * cs.x - x2 * cs.y;
          f1[i] = x2 * cs.x + x1 * cs.y;
        }
        *(uint4*)&Ks[jk][0] = pack8(f0);
        *(uint4*)&Ks[jk][8] = pack8(f1);
        if (wout) {
          *(float4*)(ok + 0) = make_float4(f0[0], f0[1], f0[2], f0[3]); *(float4*)(ok + 4) = make_float4(f0[4], f0[5], f0[6], f0[7]);
          *(float4*)(ok + 8) = make_float4(f1[0], f1[1], f1[2], f1[3]); *(float4*)(ok + 12) = make_float4(f1[4], f1[5], f1[6], f1[7]);
        }
      }
#define KREST(u, c) { float f_[8]; unpack8(u, f_); for (int j_ = 0; j_ < 8; j_++) f_[j_] = f_[j_] * rs * p.k_norm[(c) * 8 + j_]; \
        *(uint4*)&Ks[jk][(c) * 8] = pack8(f_); \
        if (wout) { *(float4*)(ok + (c) * 8) = make_float4(f_[0], f_[1], f_[2], f_[3]); *(float4*)(ok + (c) * 8 + 4) = make_float4(f_[4], f_[5], f_[6], f_[7]); } }
      KREST(k2, 2) KREST(k3, 3) KREST(k4, 4) KREST(k5, 5) KREST(k6, 6) KREST(k7, 7)
#pragma unroll 2
      for (int c = 0; c < 8; c++) {
        uint4 u = *(const uint4*)(vp + c * 8);
        Vt[c * 8 + 0][jk] = (bf16_t)(u.x & 0xffffu); Vt[c * 8 + 1][jk] = (bf16_t)(u.x >> 16);
        Vt[c * 8 + 2][jk] = (bf16_t)(u.y & 0xffffu); Vt[c * 8 + 3][jk] = (bf16_t)(u.y >> 16);
        Vt[c * 8 + 4][jk] = (bf16_t)(u.z & 0xffffu); Vt[c * 8 + 5][jk] = (bf16_t)(u.z >> 16);
        Vt[c * 8 + 6][jk] = (bf16_t)(u.w & 0xffffu); Vt[c * 8 + 7][jk] = (bf16_t)(u.w >> 16);
        if (wout) {
          float f_[8]; unpack8(u, f_);
          *(float4*)(ov + c * 8) = make_float4(f_[0], f_[1], f_[2], f_[3]); *(float4*)(ov + c * 8 + 4) = make_float4(f_[4], f_[5], f_[6], f_[7]);
        }
      }
    } else {
      uint4 z4 = make_uint4(0, 0, 0, 0);
#pragma unroll
      for (int c = 0; c < 8; c++) *(uint4*)&Ks[jk][c * 8] = z4;
#pragma unroll
      for (int d = 0; d < 64; d++) Vt[d][jk] = 0;
    }
  }
  __syncthreads();
  const int r = lane & 31, h = lane >> 5;
  const int iq = 32 * w + r;
  const int tsq = nb * 128 + iq;
  const int tokq = b * 4096 + tsq;
#pragma unroll 1
  for (int g = 0; g < 4; g++) {
    asm volatile("" ::: "memory");
    const int qh = kvh * 4 + g;
    float qf[4][8];
    const bf16_t* qp = zr + (size_t)tokq * 3584 + 2048 + qh * 64 + 8 * h;
    float ss = 0.f;
#pragma unroll
    for (int kk = 0; kk < 4; kk++) {
      uint4 u = *(const uint4*)(qp + kk * 16);
      unpack8(u, qf[kk]);
#pragma unroll
      for (int j = 0; j < 8; j++) ss += qf[kk][j] * qf[kk][j];
    }
    ss += __shfl_xor(ss, 32);
    float rs = rsqrtf(ss * (1.f / 64.f) + EPSF);
#pragma unroll
    for (int kk = 0; kk < 4; kk++)
#pragma unroll
      for (int j = 0; j < 8; j++) qf[kk][j] = qf[kk][j] * rs * p.q_norm[kk * 16 + 8 * h + j];
#pragma unroll
    for (int j = 0; j < 8; j++) {
      float2 cs = rope[tsq * 8 + j];
      float mine = qf[0][j];
      float other = __shfl_xor(mine, 32);
      qf[0][j] = (h == 0) ? (mine * cs.x - other * cs.y) : (mine * cs.x + other * cs.y);
    }
    bf16x8 bq[4];
#pragma unroll
    for (int kk = 0; kk < 4; kk++) {
      float f[8];
#pragma unroll
      for (int j = 0; j < 8; j++) f[j] = qf[kk][j] * 0.125f;
      uint4 u = pack8(f);
      bq[kk] = *(bf16x8*)&u;
    }
    f32x16 s[5];
#pragma unroll
    for (int kt = 0; kt < 5; kt++) {
#pragma unroll
      for (int e = 0; e < 16; e++) s[kt][e] = 0.f;
#pragma unroll
      for (int kk = 0; kk < 4; kk++) {
        bf16x8 a = *(const bf16x8*)&Ks[32 * (w + kt) + r][kk * 16 + 8 * h];
        s[kt] = __builtin_amdgcn_mfma_f32_32x32x16_bf16(a, bq[kk], s[kt], 0, 0, 0);
      }
    }
    const float sink = p.attn_sinks[qh];
    float m = -3e38f;
#pragma unroll
    for (int e = 0; e < 16; e++) {
      int jr = (e & 3) + 8 * (e >> 2) + 4 * h;
      s[0][e] = (jr > r) ? s[0][e] : -1e30f;
      s[4][e] = (jr <= r) ? s[4][e] : -1e30f;
    }
    if (nb == 0) {
#pragma unroll
      for (int kt = 0; kt < 4; kt++)
        if (w + kt < 4) {
#pragma unroll
          for (int e = 0; e < 16; e++) s[kt][e] = -1e30f;
        }
    }
#pragma unroll
    for (int kt = 0; kt < 5; kt++)
#pragma unroll
      for (int e = 0; e < 16; e++) m = fmaxf(m, s[kt][e]);
    m = fmaxf(m, __shfl_xor(m, 32));
    m = fmaxf(m, sink);
    float l = 0.f;
#pragma unroll
    for (int kt = 0; kt < 5; kt++)
#pragma unroll
      for (int e = 0; e < 16; e++) { float pv = __expf(s[kt][e] - m); s[kt][e] = pv; l += pv; }
    l += __shfl_xor(l, 32);
    l += __expf(sink - m);
    const float linv = 1.f / l;
    f32x16 o[2];
#pragma unroll
    for (int e = 0; e < 16; e++) { o[0][e] = 0.f; o[1][e] = 0.f; }
#pragma unroll
    for (int kt = 0; kt < 5; kt++)
#pragma unroll
      for (int u2 = 0; u2 < 2; u2++) {
        float f[8];
#pragma unroll
        for (int j = 0; j < 8; j++) f[j] = s[kt][8 * u2 + j];
        uint4 pu = pack8(f);
        bf16x8 pb = *(bf16x8*)&pu;
        int kb = 32 * (w + kt) + 16 * u2 + 4 * h;
#pragma unroll
        for (int dt = 0; dt < 2; dt++) {
          uint2 v0 = *(const uint2*)&Vt[32 * dt + r][kb];
          uint2 v1 = *(const uint2*)&Vt[32 * dt + r][kb + 8];
          uint4 va = make_uint4(v0.x, v0.y, v1.x, v1.y);
          o[dt] = __builtin_amdgcn_mfma_f32_32x32x16_bf16(*(bf16x8*)&va, pb, o[dt], 0, 0, 0);
        }
      }
    bf16_t* op = obuf + (size_t)tokq * 1024 + qh * 64;
#pragma unroll
    for (int dt = 0; dt < 2; dt++)
#pragma unroll
      for (int e4 = 0; e4 < 4; e4++) {
        int d = 32 * dt + 8 * e4 + 4 * h;
        uint2 st;
        st.x = pack2(o[dt][4 * e4 + 0] * linv, o[dt][4 * e4 + 1] * linv);
        st.y = pack2(o[dt][4 * e4 + 2] * linv, o[dt][4 * e4 + 3] * linv);
        *(uint2*)(op + d) = st;
      }
  }
}

__device__ void attn_sample_item(CParams& p, int db, char* smem) {
  const int t = threadIdx.x, lane = t & 63, w = t >> 6;
  const int kvh = w;
  float* qs = (float*)smem + w * 1024;
  float* knew = (float*)smem + 4096 + w * 256;
  float* vnew = (float*)smem + 5120 + w * 256;
  float* ps = (float*)smem + 6144 + w * (16 * 132);
  const bf16_t* zr = (const bf16_t*)(p.ws + OFF_ZR);
  const float2* rope = (const float2*)(p.ws + OFF_ROPE);
  bf16_t* obuf = (bf16_t*)(p.ws + OFF_R1) + (size_t)NTOK * 1024;
  const int tok0 = NPROMPT + db * 4;
  __syncthreads();
  {
    int row = lane >> 4, part = lane & 15, d0 = part * 4;
    const bf16_t* kp = zr + (size_t)(tok0 + row) * 3584 + 3072 + kvh * 64 + d0;
    const bf16_t* vp = zr + (size_t)(tok0 + row) * 3584 + 3328 + kvh * 64 + d0;
    uint2 ku = *(const uint2*)kp, vu = *(const uint2*)vp;
    float kf[4] = {lo2f(ku.x), hi2f(ku.x), lo2f(ku.y), hi2f(ku.y)};
    float vf[4] = {lo2f(vu.x), hi2f(vu.x), lo2f(vu.y), hi2f(vu.y)};
    float ss = kf[0] * kf[0] + kf[1] * kf[1] + kf[2] * kf[2] + kf[3] * kf[3];
    ss += __shfl_xor(ss, 1); ss += __shfl_xor(ss, 2); ss += __shfl_xor(ss, 4); ss += __shfl_xor(ss, 8);
    float rs = rsqrtf(ss * (1.f / 64.f) + EPSF);
#pragma unroll
    for (int j = 0; j < 4; j++) kf[j] = kf[j] * rs * p.k_norm[d0 + j];
#pragma unroll
    for (int j = 0; j < 4; j++) {
      float other = __shfl_xor(kf[j], 2);
      if (part < 4) {
        float2 cs = rope[(4096 + row) * 8 + ((d0 + j) & 7)];
        kf[j] = (part < 2) ? (kf[j] * cs.x - other * cs.y) : (kf[j] * cs.x + other * cs.y);
      }
    }
    float* ok = p.out + O_SK + (size_t)((db * 128 + 124 + row) * 4 + kvh) * 64 + d0;
    float* ov = p.out + O_SV + (size_t)((db * 128 + 124 + row) * 4 + kvh) * 64 + d0;
#pragma unroll
    for (int j = 0; j < 4; j++) { knew[row * 64 + d0 + j] = kf[j]; vnew[row * 64 + d0 + j] = vf[j]; ok[j] = kf[j]; ov[j] = vf[j]; }
  }
  {
    int qrow = lane >> 2, part = lane & 3, g = qrow >> 2, tq = qrow & 3, d0 = part * 16;
    int qh = kvh * 4 + g;
    const bf16_t* qp = zr + (size_t)(tok0 + tq) * 3584 + 2048 + qh * 64 + d0;
    float qf[16];
    unpack8(*(const uint4*)qp, qf); unpack8(*(const uint4*)(qp + 8), qf + 8);
    float ss = 0.f;
#pragma unroll
    for (int j = 0; j < 16; j++) ss += qf[j] * qf[j];
    ss += __shfl_xor(ss, 1); ss += __shfl_xor(ss, 2);
    float rs = rsqrtf(ss * (1.f / 64.f) + EPSF);
#pragma unroll
    for (int j = 0; j < 16; j++) qf[j] = qf[j] * rs * p.q_norm[d0 + j];
    if (part == 0) {
#pragma unroll
      for (int i = 0; i < 8; i++) {
        float2 cs = rope[(4096 + tq) * 8 + i];
        float x1 = qf[i], x2 = qf[i + 8];
        qf[i] = x1 * cs.x - x2 * cs.y;
        qf[i + 8] = x2 * cs.x + x1 * cs.y;
      }
    }
#pragma unroll
    for (int j = 0; j < 16; j++) qs[qrow * 64 + d0 + j] = qf[j] * 0.125f;
  }
  __syncthreads();
#pragma unroll 1
  for (int sl = 0; sl < 3; sl++) {
    int j = lane + 64 * sl;
    if (j < 132) {
      float scq[16];
#pragma unroll
      for (int q = 0; q < 16; q++) scq[q] = 0.f;
      const float* kr = (j < 128) ? p.cache_k + (size_t)((db * 128 + j) * 4 + kvh) * 64 : knew + (j - 128) * 64;
#pragma unroll 2
      for (int d = 0; d < 64; d += 4) {
        float4 kv = *(const float4*)(kr + d);
        if (j >= 4 && j < 128) *(float4*)(p.out + O_SK + (size_t)((db * 128 + j - 4) * 4 + kvh) * 64 + d) = kv;
#pragma unroll
        for (int q = 0; q < 16; q++) {
          float4 qv = *(const float4*)(qs + q * 64 + d);
          scq[q] += kv.x * qv.x + kv.y * qv.y + kv.z * qv.z + kv.w * qv.w;
        }
      }
#pragma unroll
      for (int q = 0; q < 16; q++) ps[q * 132 + j] = scq[q];
    }
  }
#pragma unroll 1
  for (int q = 0; q < 16; q++) {
    int g = q >> 2, tq = q & 3;
    float sink = p.attn_sinks[kvh * 4 + g];
    float m = -3e38f;
    float sv[3];
#pragma unroll
    for (int sl = 0; sl < 3; sl++) {
      int j = lane + 64 * sl;
      bool valid = (j < 132) && (j >= tq + 1) && (j <= tq + 128);
      float v = valid ? ps[q * 132 + j] : -1e30f;
      sv[sl] = v;
      m = fmaxf(m, v);
    }
    m = fmaxf(wave_max(m), sink);
    float l = 0.f;
#pragma unroll
    for (int sl = 0; sl < 3; sl++) { float pv = __expf(sv[sl] - m); sv[sl] = pv; l += pv; }
    l = wave_sum(l) + __expf(sink - m);
    float linv = 1.f / l;
#pragma unroll
    for (int sl = 0; sl < 3; sl++) {
      int j = lane + 64 * sl;
      if (j < 132) ps[q * 132 + j] = sv[sl] * linv;
    }
  }
  __syncthreads();
  float oacc[16];
#pragma unroll
  for (int q = 0; q < 16; q++) oacc[q] = 0.f;
  for (int j = 0; j < 132; j++) {
    float vv;
    if (j < 128) {
      vv = p.cache_v[(size_t)((db * 128 + j) * 4 + kvh) * 64 + lane];
      if (j >= 4) p.out[O_SV + (size_t)((db * 128 + j - 4) * 4 + kvh) * 64 + lane] = vv;
    } else vv = vnew[(j - 128) * 64 + lane];
#pragma unroll
    for (int q = 0; q < 16; q++) oacc[q] += ps[q * 132 + j] * vv;
  }
#pragma unroll
  for (int q = 0; q < 16; q++) {
    int g = q >> 2, tq = q & 3;
    obuf[(size_t)(tok0 + tq) * 1024 + (kvh * 4 + g) * 64 + lane] = f2bf(oacc[q]);
  }
}

#ifndef ONLY2
#define ONLY2 -1
#endif
#define P2_ON(n) (true)
__device__ void phase_mix(CParams& p, char* smem) {
  if (P2_ON(0))
    for (int it = blockIdx.x; it < 512; it += gridDim.x) {
      CParams& q = *get_params();
      attn_prompt_item(q, it >> 7, (it >> 2) & 31, it & 3, smem);
    }
  if (P2_ON(1))
    for (int it = blockIdx.x; it < 1056; it += gridDim.x) {
      CParams& q = *get_params();
      rglru_tile(q, it >> 3, it & 7, smem);
    }
  if (P2_ON(2))
    for (int it = (int)gridDim.x - 1 - (int)blockIdx.x; it < 128; it += gridDim.x) {
      CParams& q = *get_params();
      attn_sample_item(q, it, smem);
    }
}

__device__ void phase_scan1(CParams& p) {}
__device__ void phase_scan2(CParams& p) {
  const unsigned* ab_arr = (const unsigned*)p.out;
  const float* sumP = (const float*)(p.ws + OFF_SUM);
  const float* sumH = sumP + 524288;
  const bf16_t* zr = (const bf16_t*)(p.ws + OFF_ZR);
  bf16_t* hg = (bf16_t*)(p.ws + OFF_R1);
  for (int it = blockIdx.x; it < 512 + 512; it += gridDim.x) {
    if (it < 512) {
      int id = it * 256 + threadIdx.x;
      int ch = id & 1023, cg = (id >> 10) & 31, b = id >> 15;
      float h = 0.f;
      const float* sp = sumP + (size_t)(b * 128) * 1024 + ch;
      const float* sh = sumH + (size_t)(b * 128) * 1024 + ch;
      {
        const int nprev = cg * 4;
        int c = 0;
        for (; c + 16 <= nprev; c += 16) {
          float pp[16], ph_[16];
#pragma unroll
          for (int u = 0; u < 16; u++) { pp[u] = sp[(size_t)(c + u) * 1024]; ph_[u] = sh[(size_t)(c + u) * 1024]; }
#pragma unroll
          for (int u = 0; u < 16; u++) h = pp[u] * h + ph_[u];
        }
        for (; c < nprev; c++) h = sp[(size_t)c * 1024] * h + sh[(size_t)c * 1024];
      }
#pragma unroll 1
      for (int sub = 0; sub < 4; sub++) {
        size_t tok0 = (size_t)b * 4096 + (cg * 4 + sub) * 32;
        unsigned wv[32]; float gv[32];
#pragma unroll
        for (int s2 = 0; s2 < 32; s2++) {
          size_t tok = tok0 + s2;
          wv[s2] = ab_arr[tok * 1024 + ch];
          gv[s2] = bf2f(zr[tok * 3584 + 1024 + ch]);
        }
#pragma unroll
        for (int s2 = 0; s2 < 32; s2++) {
          h = (1.f - hi2f(wv[s2])) * h + lo2f(wv[s2]);
          hg[(tok0 + s2) * 1024 + ch] = f2bf(h * gv[s2]);
        }
      }
      if (cg == 31) p.out[O_PRG + b * 1024 + ch] = h;
    } else {
      int id = (it - 512) * 256 + threadIdx.x;
      int ch = id & 1023, db = id >> 10;
      float h = p.state_rglru[db * 1024 + ch];
#pragma unroll
      for (int dt = 0; dt < 4; dt++) {
        size_t tok = NPROMPT + db * 4 + dt;
        const unsigned wv = ab_arr[tok * 1024 + ch];
        h = (1.f - hi2f(wv)) * h + lo2f(wv);
        float gg = bf2f(zr[tok * 3584 + 1024 + ch]);
        hg[tok * 1024 + ch] = f2bf(h * gg);
      }
      p.out[O_SRG + db * 1024 + ch] = h;
    }
  }
}

__device__ void phase_proj(CParams& p, char* smem) {
  EPI_VARS
  const bf16_t* hg = (const bf16_t*)(p.ws + OFF_R1);
  const bf16_t* ob = hg + (size_t)NTOK * 1024;
  const bf16_t* wsw = (const bf16_t*)(p.ws + OFF_W);
  const bf16_t* zg = (const bf16_t*)(p.ws + OFF_ZG);
  bf16_t* merged = (bf16_t*)(p.ws + OFF_ZR);
  const int x = blockIdx.x & 7, per = gridDim.x >> 3;
  if ((int)blockIdx.x >= per * 8) return;
  for (int q = blockIdx.x >> 3;; q += per) {
    int mt, nt;
    if (!tile_at(q, x, 1, 16, 88, 1, mt, nt)) break;
    f32x4 acc[4][6];
    zero_acc6(acc);
    gemm_loop3(acc, hg + (size_t)mt * 192 * 1024, 1024, wsw + W_RNN + (size_t)nt * 128 * 1024, 1024, 1024, smem);
    {
    const uint4* gat = (const uint4*)zg + ((size_t)(mt * 32 + nt) * 12) * 256 + opaque_u(threadIdx.x);
    uint4* ptl = (uint4*)p.out + ((size_t)(mt * 16 + nt) * 12) * 256 + opaque_u(threadIdx.x);
#pragma unroll
    for (int mm = 0; mm < 6; mm++)
#pragma unroll
      for (int n2 = 0; n2 < 2; n2++) {
        const uint4 g = gat[(mm * 2 + n2) * 256];
        uint4 o;
        o.x = pack2(acc[2 * n2][mm][0] * lo2f(g.x), acc[2 * n2][mm][1] * hi2f(g.x));
        o.y = pack2(acc[2 * n2][mm][2] * lo2f(g.y), acc[2 * n2][mm][3] * hi2f(g.y));
        o.z = pack2(acc[2 * n2 + 1][mm][0] * lo2f(g.z), acc[2 * n2 + 1][mm][1] * hi2f(g.z));
        o.w = pack2(acc[2 * n2 + 1][mm][2] * lo2f(g.w), acc[2 * n2 + 1][mm][3] * hi2f(g.w));
        ptl[(mm * 2 + n2) * 256] = o;
      }
    }
    zero_acc6(acc);
    gemm_loop3(acc, ob + (size_t)mt * 192 * 1024, 1024, wsw + W_ATT + (size_t)nt * 128 * 1024, 1024, 1024, smem);
    asm volatile("" ::: "memory");
    {
      bf16_t (*T)[136] = (bf16_t (*)[136])smem;
      __syncthreads();
      const uint4* gbt = (const uint4*)zg + ((size_t)(mt * 32 + 16 + nt) * 12) * 256 + opaque_u(threadIdx.x);
      const uint4* ptl = (const uint4*)p.out + ((size_t)(mt * 16 + nt) * 12) * 256 + opaque_u(threadIdx.x);
      bf16_t* mgt = merged + (size_t)mt * 192 * 2048 + nt * 128;
      const unsigned lrow = opaque_u(LROW3), lcol = opaque_u(LCOL2);
#pragma unroll
      for (int mm = 0; mm < 6; mm++)
#pragma unroll
        for (int n2 = 0; n2 < 2; n2++) {
          const uint4 g = gbt[(mm * 2 + n2) * 256];
          const uint4 pm = ptl[(mm * 2 + n2) * 256];
          *(uint2*)&T[lrow + mm * 16][lcol + (2 * n2) * 16] =
              make_uint2(pack2(lo2f(pm.x) + acc[2 * n2][mm][0] * lo2f(g.x), hi2f(pm.x) + acc[2 * n2][mm][1] * hi2f(g.x)),
                         pack2(lo2f(pm.y) + acc[2 * n2][mm][2] * lo2f(g.y), hi2f(pm.y) + acc[2 * n2][mm][3] * hi2f(g.y)));
          *(uint2*)&T[lrow + mm * 16][lcol + (2 * n2 + 1) * 16] =
              make_uint2(pack2(lo2f(pm.z) + acc[2 * n2 + 1][mm][0] * lo2f(g.z), hi2f(pm.z) + acc[2 * n2 + 1][mm][1] * hi2f(g.z)),
                         pack2(lo2f(pm.w) + acc[2 * n2 + 1][mm][2] * lo2f(g.w), hi2f(pm.w) + acc[2 * n2 + 1][mm][3] * hi2f(g.w)));
        }
      __syncthreads();
      const unsigned tt = opaque_u(threadIdx.x);
#pragma unroll
      for (int i = 0; i < 12; i++) {
        const unsigned c = tt + 256u * i, row = c >> 4, ch = (c & 15u) * 8u;
        *(uint4*)(mgt + (size_t)row * 2048 + ch) = *(const uint4*)&T[row][ch];
      }
    }
  }
}

__device__ void phase_wout(CParams& p, char* smem) {
  EPI_VARS
  const bf16_t* merged = (const bf16_t*)(p.ws + OFF_ZR);
  const bf16_t* wsw = (const bf16_t*)(p.ws + OFF_W);
  bf16_t* x1b = (bf16_t*)(p.ws + OFF_R1);
  const int x = blockIdx.x & 7, per = gridDim.x >> 3;
  if ((int)blockIdx.x >= per * 8) return;
  for (int q = blockIdx.x >> 3;; q += per) {
    int mt, nt;
    if (!tile_at(q, x, 1, 16, 88, 1, mt, nt)) break;
    f32x4 acc[4][6];
    zero_acc6(acc);
    gemm_loop3(acc, merged + (size_t)mt * 192 * 2048, 2048, wsw + W_OUT + (size_t)nt * 128 * 2048, 2048, 2048, smem);
    float* yt = p.out + O_Y + (size_t)mt * 192 * 2048 + nt * 128;
    bf16_t* xbt = x1b + (size_t)mt * 192 * 2048 + nt * 128;
    const unsigned lo = opaque_u(LROW3 * 2048 + LCOL2);
    const int colx = nt * 128 + LCOL2;
    bf16_t (*T)[136] = (bf16_t (*)[136])smem;
    __syncthreads();
    const unsigned lrow = opaque_u(LROW3), lcol = opaque_u(LCOL2);
#pragma unroll
    for (int mm = 0; mm < 6; mm++) {
      const float* xr = x_row(p, mt * 192 + LROW3 + mm * 16) + colx;
#pragma unroll
      for (int nn = 0; nn < 4; nn++) {
        unsigned o = lo + (unsigned)(mm * 16 * 2048 + nn * 16);
        float4 xv = *(const float4*)(xr + nn * 16);
        float4 v = make_float4(xv.x + acc[nn][mm][0], xv.y + acc[nn][mm][1], xv.z + acc[nn][mm][2], xv.w + acc[nn][mm][3]);
        *(float4*)(yt + o) = v;
        *(uint2*)&T[lrow + mm * 16][lcol + nn * 16] = make_uint2(pack2(v.x, v.y), pack2(v.z, v.w));
      }
    }
    __syncthreads();
    const unsigned tt = opaque_u(threadIdx.x);
#pragma unroll
    for (int i = 0; i < 12; i++) {
      const unsigned c = tt + 256u * i, row = c >> 4, ch = (c & 15u) * 8u;
      *(uint4*)(xbt + (size_t)row * 2048 + ch) = *(const uint4*)&T[row][ch];
    }
  }
}

__device__ void phase_pq(CParams& p, char* smem) {
  EPI_VARS
  const bf16_t* x1b = (const bf16_t*)(p.ws + OFF_R1);
  const bf16_t* wsw = (const bf16_t*)(p.ws + OFF_W);
  float* scores = (float*)(p.ws + OFF_ZG);
  bf16_t (*A2)[136] = (bf16_t (*)[136])smem;
  bf16_t (*B2)[136] = (bf16_t (*)[136])(smem + 34816);
  const int x = blockIdx.x & 7, per = gridDim.x >> 3;
  if ((int)blockIdx.x >= per * 8) return;
  for (int q = blockIdx.x >> 3;; q += per) {
    int mt, nt;
    if (!tile_at(q, x, 1, 16, 132, 1, mt, nt)) break;
    {
      f32x4 acc4[4][4];
      zero_acc4(acc4);
      gemm_loop(acc4, x1b + (size_t)mt * 128 * 2048, 2048, wsw + W_PQ + (size_t)nt * 128 * 2048, 2048, 2048, smem);
      __syncthreads();
#pragma unroll
      for (int mm = 0; mm < 4; mm++)
#pragma unroll
        for (int nn = 0; nn < 4; nn++)
          *(uint2*)&A2[LROW2 + mm * 16][LCOL2 + nn * 16] =
              make_uint2(pack2(acc4[nn][mm][0], acc4[nn][mm][1]), pack2(acc4[nn][mm][2], acc4[nn][mm][3]));
    }
    load_b2(B2, wsw + W_SK + (size_t)nt * 16384);
    __syncthreads();
    f32x16 acc[2][2];
    zero_acc(acc);
    lds_gemm128(acc, A2, B2);
    bf16_t* sct = (bf16_t*)scores + (size_t)mt * 128 * 2048 + nt * 128;
    bf16_t (*S)[136] = (bf16_t (*)[136])smem;
    __syncthreads();
    {
      const unsigned lrow = opaque_u(LROW), lcol = opaque_u(LCOL);
#pragma unroll
      for (int i = 0; i < 2; i++)
#pragma unroll
        for (int j = 0; j < 2; j++)
#pragma unroll
          for (int r = 0; r < 16; r++) S[lrow + ROWC(i, r)][lcol + j * 32] = f2bf(acc[i][j][r]);
    }
    __syncthreads();
    {
      const unsigned tt = opaque_u(threadIdx.x);
#pragma unroll
      for (int i = 0; i < 8; i++) {
        const unsigned c = tt + 256u * i, row = c >> 4, ch = (c & 15u) * 8u;
        *(uint4*)(sct + (size_t)row * 2048 + ch) = *(const uint4*)&S[row][ch];
      }
    }
  }
}

__device__ __forceinline__ unsigned f2key(float f) {
  unsigned u = __float_as_uint(f);
  return (u & 0x80000000u) ? ~u : (u | 0x80000000u);
}
#define WAVE_LDS_SYNC() asm volatile("s_waitcnt lgkmcnt(0)" ::: "memory")
template <int NV>
__device__ __forceinline__ void wave_top16(const unsigned (&key)[NV], bool (&sel)[NV], int (&pos)[NV], int lane) {
  unsigned prefix = 0;
  int bit = 31;
  bool done = false;
  {
    int c0 = 0, c1 = 0, c2 = 0, c3 = 0, c4 = 0, c5 = 0;
#pragma unroll
    for (int m = 0; m < NV; m++) {
      c0 += __popcll(__ballot(key[m] >= 0xBF000000u));
      c1 += __popcll(__ballot(key[m] >= 0xBF800000u));
      c2 += __popcll(__ballot(key[m] >= 0xC0000000u));
      c3 += __popcll(__ballot(key[m] >= 0xC0800000u));
      c4 += __popcll(__ballot(key[m] >= 0xC1000000u));
      c5 += __popcll(__ballot(key[m] >= 0xC1800000u));
    }
    if (c0 >= 16 && c5 < 16) {
      unsigned pf = 0xBF000000u; int cp = c0;
      if (c1 >= 16) { pf = 0xBF800000u; cp = c1; }
      if (c2 >= 16) { pf = 0xC0000000u; cp = c2; }
      if (c3 >= 16) { pf = 0xC0800000u; cp = c3; }
      if (c4 >= 16) { pf = 0xC1000000u; cp = c4; }
      prefix = pf;
      bit = 22;
      done = (cp == 16);
    }
  }
  for (; bit >= 0 && !done; --bit) {
    unsigned T = prefix | (1u << bit);
    int cnt = 0;
#pragma unroll
    for (int m = 0; m < NV; m++) cnt += __popcll(__ballot(key[m] >= T));
    if (cnt >= 16) prefix = T;
    if (cnt == 16) break;
  }
  const unsigned long long lt = (1ull << lane) - 1ull;
  int ngt = 0;
#pragma unroll
  for (int m = 0; m < NV; m++) ngt += __popcll(__ballot(key[m] > prefix));
  const int need = 16 - ngt;
  int eqb = 0, selb = 0;
#pragma unroll
  for (int m = 0; m < NV; m++) {
    bool gt = key[m] > prefix, eq = key[m] == prefix;
    unsigned long long em = __ballot(eq);
    int er = eqb + __popcll(em & lt);
    bool s = gt || (eq && er < need);
    unsigned long long sm = __ballot(s);
    sel[m] = s;
    pos[m] = selb + __popcll(sm & lt);
    eqb += __popcll(em);
    selb += __popcll(sm);
  }
}

__device__ void peer_token(CParams& p, int tok, char* smem) {
  const int t = threadIdx.x, lane = t & 63, w = t >> 6;
  float* s_sc = (float*)smem;
  float* s_part = s_sc + 2048;
  float* s_red = s_part + 8192;
  float* s_sel_s = s_red + 64;
  int* s_sel_i = (int*)(s_sel_s + 128);
  float* s_ew = (float*)(s_sel_i + 128);
  int* s_ei = (int*)(s_ew + 128);
  const bf16_t* scores = (const bf16_t*)(p.ws + OFF_ZG) + (size_t)tok * 2048;
  float* yrow = p.out + O_Y + (size_t)tok * 2048;
  __syncthreads();
  float4 xa = *(const float4*)(yrow + t * 8), xb = *(const float4*)(yrow + t * 8 + 4);
  float ss = xa.x * xa.x + xa.y * xa.y + xa.z * xa.z + xa.w * xa.w + xb.x * xb.x + xb.y * xb.y + xb.z * xb.z + xb.w * xb.w;
  ss = wave_sum(ss);
  if (lane == 0) s_red[w] = ss;
  {
    float sf[8];
    unpack8(*(const uint4*)(scores + t * 8), sf);
    *(float4*)(s_sc + t * 8) = make_float4(sf[0], sf[1], sf[2], sf[3]);
    *(float4*)(s_sc + t * 8 + 4) = make_float4(sf[4], sf[5], sf[6], sf[7]);
  }
  __syncthreads();
  const float rs = rsqrtf((s_red[0] + s_red[1] + s_red[2] + s_red[3]) * (1.f / 2048.f) + EPSF);
  float xn[32];
#pragma unroll
  for (int c = 0; c < 2; c++)
#pragma unroll
    for (int q4 = 0; q4 < 4; q4++) {
      float4 a = *(const float4*)(yrow + c * 1024 + lane * 16 + q4 * 4);
      float4 g = *(const float4*)(p.norm_ffn + c * 1024 + lane * 16 + q4 * 4);
      xn[c * 16 + q4 * 4 + 0] = a.x * rs * g.x; xn[c * 16 + q4 * 4 + 1] = a.y * rs * g.y;
      xn[c * 16 + q4 * 4 + 2] = a.z * rs * g.z; xn[c * 16 + q4 * 4 + 3] = a.w * rs * g.w;
    }
  for (int hh = 0; hh < 2; hh++) {
    const int h = 2 * w + hh;
#pragma unroll
    for (int pp = 0; pp < 2; pp++) {
      const int base = (h * 2 + pp) * 128;
      float v[2] = {s_sc[base + lane], s_sc[base + 64 + lane]};
      unsigned key[2] = {f2key(v[0]), f2key(v[1])};
      bool sel[2]; int pos[2];
      wave_top16<2>(key, sel, pos, lane);
#pragma unroll
      for (int m = 0; m < 2; m++)
        if (sel[m]) { s_sel_s[(w * 2 + pp) * 16 + pos[m]] = v[m]; s_sel_i[(w * 2 + pp) * 16 + pos[m]] = lane + 64 * m; }
    }
    WAVE_LDS_SYNC();
    {
      float s2v = s_sel_s[(w * 2 + 1) * 16 + (lane & 15)];
      float cand[4]; unsigned key[4]; bool sel[4]; int pos[4];
#pragma unroll
      for (int m = 0; m < 4; m++) { cand[m] = s_sel_s[(w * 2) * 16 + (lane >> 4) + 4 * m] + s2v; key[m] = f2key(cand[m]); }
      wave_top16<4>(key, sel, pos, lane);
#pragma unroll
      for (int m = 0; m < 4; m++)
        if (sel[m]) {
          s_ew[h * 16 + pos[m]] = cand[m];
          s_ei[h * 16 + pos[m]] = s_sel_i[(w * 2) * 16 + (lane >> 4) + 4 * m] * 128 + s_sel_i[(w * 2 + 1) * 16 + (lane & 15)];
        }
    }
    WAVE_LDS_SYNC();
    {
      float val = s_ew[h * 16 + (lane & 15)] * rs;
      float m = val;
      m = fmaxf(m, __shfl_xor(m, 1)); m = fmaxf(m, __shfl_xor(m, 2)); m = fmaxf(m, __shfl_xor(m, 4)); m = fmaxf(m, __shfl_xor(m, 8));
      float e = __expf(val - m);
      float sum = e;
      sum += __shfl_xor(sum, 1); sum += __shfl_xor(sum, 2); sum += __shfl_xor(sum, 4); sum += __shfl_xor(sum, 8);
      if (lane < 16) s_ew[h * 16 + lane] = e / sum;
    }
    WAVE_LDS_SYNC();
  }
  float acc[32];
#pragma unroll
  for (int j = 0; j < 32; j++) acc[j] = 0.f;
#define FP8_DOT(u4, xo, hacc) {                                                        \
    const unsigned d_[4] = {u4.x, u4.y, u4.z, u4.w};                                    \
    for (int q_ = 0; q_ < 4; q_++) {                                                    \
      auto lo_ = __builtin_amdgcn_cvt_pk_f32_fp8((int)d_[q_], false);                   \
      auto hi_ = __builtin_amdgcn_cvt_pk_f32_fp8((int)d_[q_], true);                    \
      hacc += lo_[0] * xn[(xo) + q_ * 4 + 0] + lo_[1] * xn[(xo) + q_ * 4 + 1] +         \
              hi_[0] * xn[(xo) + q_ * 4 + 2] + hi_[1] * xn[(xo) + q_ * 4 + 3];          \
    } }
#define FP8_AXPY(u4, xo, wgt) {                                                        \
    const unsigned d_[4] = {u4.x, u4.y, u4.z, u4.w};                                    \
    for (int q_ = 0; q_ < 4; q_++) {                                                    \
      auto lo_ = __builtin_amdgcn_cvt_pk_f32_fp8((int)d_[q_], false);                   \
      auto hi_ = __builtin_amdgcn_cvt_pk_f32_fp8((int)d_[q_], true);                    \
      acc[(xo) + q_ * 4 + 0] += wgt * lo_[0]; acc[(xo) + q_ * 4 + 1] += wgt * lo_[1];   \
      acc[(xo) + q_ * 4 + 2] += wgt * hi_[0]; acc[(xo) + q_ * 4 + 3] += wgt * hi_[1];   \
    } }
  const unsigned char* U8 = (const unsigned char*)(p.ws + OFF_U);
  const unsigned char* V8 = (const unsigned char*)(p.ws + OFF_V);
  uint4 ru[4][2], rv[4][2];
  float g[4];
  {
#pragma unroll
    for (int u = 0; u < 4; u++) {
      const int e = s_ei[w * 32 + u];
      g[u] = s_ew[w * 32 + u];
      const uint4* up = (const uint4*)(U8 + (size_t)e * 2048) + lane;
      ru[u][0] = up[0]; ru[u][1] = up[64];
    }
#pragma unroll
    for (int u = 0; u < 4; u++) {
      const int e = s_ei[w * 32 + u];
      const uint4* vp = (const uint4*)(V8 + (size_t)e * 2048) + lane;
      rv[u][0] = vp[0]; rv[u][1] = vp[64];
    }
  }
#pragma unroll 1
  for (int q = 0; q < 32; q += 4) {
    float hh[4];
#pragma unroll
    for (int u = 0; u < 4; u++) {
      float ha = 0.f;
#pragma unroll
      for (int c = 0; c < 2; c++) FP8_DOT(ru[u][c], c * 16, ha)
      hh[u] = ha;
    }
    const int qn = (q + 4 < 32) ? q + 4 : q;
    float gn[4];
#pragma unroll
    for (int u = 0; u < 4; u++) {
      const int e = s_ei[w * 32 + qn + u];
      gn[u] = s_ew[w * 32 + qn + u];
      const uint4* up = (const uint4*)(U8 + (size_t)e * 2048) + lane;
      ru[u][0] = up[0]; ru[u][1] = up[64];
    }
#pragma unroll
    for (int o = 32; o; o >>= 1) {
#pragma unroll
      for (int u = 0; u < 4; u++) hh[u] += __shfl_xor(hh[u], o);
    }
#pragma unroll
    for (int u = 0; u < 4; u++) {
      const float wg = gelu_tanh(hh[u] * (1.f / 1024.f)) * g[u] * (1.f / 256.f);
#pragma unroll
      for (int c = 0; c < 2; c++) FP8_AXPY(rv[u][c], c * 16, wg)
    }
#pragma unroll
    for (int u = 0; u < 4; u++) {
      const int e = s_ei[w * 32 + qn + u];
      const uint4* vp = (const uint4*)(V8 + (size_t)e * 2048) + lane;
      rv[u][0] = vp[0]; rv[u][1] = vp[64];
      g[u] = gn[u];
    }
  }
#pragma unroll
  for (int c = 0; c < 2; c++) {
    float* d = s_part + w * 2048 + c * 1024 + lane * 16;
#pragma unroll
    for (int q4 = 0; q4 < 4; q4++)
      *(float4*)(d + q4 * 4) = make_float4(acc[c * 16 + q4 * 4 + 0], acc[c * 16 + q4 * 4 + 1], acc[c * 16 + q4 * 4 + 2], acc[c * 16 + q4 * 4 + 3]);
  }
  __syncthreads();
  float x2[8] = {xa.x, xa.y, xa.z, xa.w, xb.x, xb.y, xb.z, xb.w};
#pragma unroll
  for (int ww = 0; ww < 4; ww++) {
    float4 a = *(const float4*)(s_part + ww * 2048 + t * 8), b = *(const float4*)(s_part + ww * 2048 + t * 8 + 4);
    x2[0] += a.x; x2[1] += a.y; x2[2] += a.z; x2[3] += a.w; x2[4] += b.x; x2[5] += b.y; x2[6] += b.z; x2[7] += b.w;
  }
  *(float4*)(yrow + t * 8) = make_float4(x2[0], x2[1], x2[2], x2[3]);
  *(float4*)(yrow + t * 8 + 4) = make_float4(x2[4], x2[5], x2[6], x2[7]);
  float ss2 = 0.f;
#pragma unroll
  for (int j = 0; j < 8; j++) ss2 += x2[j] * x2[j];
  ss2 = wave_sum(ss2);
  if (lane == 0) s_red[8 + w] = ss2;
  __syncthreads();
  const float rs2 = rsqrtf((s_red[8] + s_red[9] + s_red[10] + s_red[11]) * (1.f / 2048.f) + EPSF);
  {
    const float* g = p.norm_ple + t * 8;
    float f[8];
#pragma unroll
    for (int j = 0; j < 8; j++) f[j] = x2[j] * rs2 * g[j];
    *(uint4*)((bf16_t*)(p.ws + OFF_ZR) + (size_t)tok * 2048 + t * 8) = pack8(f);
    ((bf16_t*)(p.ws + OFF_PLB))[(size_t)tok * 256 + t] = f2bf(ple_row(p, tok)[t]);
  }
}
__device__ void phase_peer(CParams& p, char* smem) {
  for (int tok = blockIdx.x; tok < NTOK; tok += gridDim.x) peer_token(p, tok, smem);
}

__device__ void phase_ple(CParams& p, char* smem) {
  EPI_VARS
  const bf16_t* plb = (const bf16_t*)(p.ws + OFF_PLB);
  const bf16_t* x2n = (const bf16_t*)(p.ws + OFF_ZR);
  const bf16_t* wsw = (const bf16_t*)(p.ws + OFF_W);
  const int x = blockIdx.x & 7, per = gridDim.x >> 3;
  if ((int)blockIdx.x >= per * 8) return;
  for (int q = blockIdx.x >> 3;; q += per) {
    int mt, nt;
    if (!tile_at(q, x, 1, 16, 88, 1, mt, nt)) break;
    f32x4 acc[4][6];
    zero_acc6(acc);
    gemm_loop3(acc, plb + (size_t)mt * 192 * 256, 256, wsw + W_PLE + (size_t)nt * 128 * 256, 256, 256, smem);
    uint4* tmp = (uint4*)(p.ws + OFF_ZG) + ((size_t)(mt * 16 + nt) * 12) * 256 + opaque_u(threadIdx.x);
#pragma unroll
    for (int mm = 0; mm < 6; mm++)
#pragma unroll
      for (int n2 = 0; n2 < 2; n2++) {
        uint4 o;
        o.x = pack2(acc[2 * n2][mm][0], acc[2 * n2][mm][1]);
        o.y = pack2(acc[2 * n2][mm][2], acc[2 * n2][mm][3]);
        o.z = pack2(acc[2 * n2 + 1][mm][0], acc[2 * n2 + 1][mm][1]);
        o.w = pack2(acc[2 * n2 + 1][mm][2], acc[2 * n2 + 1][mm][3]);
        tmp[(mm * 2 + n2) * 256] = o;
      }
    zero_acc6(acc);
    gemm_loop3(acc, x2n + (size_t)mt * 192 * 2048, 2048, wsw + W_GATE + (size_t)nt * 128 * 2048, 2048, 2048, smem);
    asm volatile("" ::: "memory");
    float* yt = p.out + O_Y + (size_t)mt * 192 * 2048 + nt * 128;
    const unsigned lo = opaque_u(LROW3 * 2048 + LCOL2);
#pragma unroll
    for (int mm = 0; mm < 6; mm++)
#pragma unroll
      for (int n2 = 0; n2 < 2; n2++) {
        const uint4 a1 = tmp[(mm * 2 + n2) * 256];
#pragma unroll
        for (int h2 = 0; h2 < 2; h2++) {
          const int nn = 2 * n2 + h2;
          const unsigned alo = h2 ? a1.z : a1.x, ahi = h2 ? a1.w : a1.y;
          float4* yp = (float4*)(yt + lo + (unsigned)(mm * 16 * 2048 + nn * 16));
          float4 y = *yp;
          y.x += lo2f(alo) * sigmoidf_(acc[nn][mm][0]);
          y.y += hi2f(alo) * sigmoidf_(acc[nn][mm][1]);
          y.z += lo2f(ahi) * sigmoidf_(acc[nn][mm][2]);
          y.w += hi2f(ahi) * sigmoidf_(acc[nn][mm][3]);
          *yp = y;
        }
      }
  }
}

#define XB_TMO      128
#define XB_XCNT(j)  (256  + 64 * (j))
#define XB_XSUB(j)  (1280 + 64 * (j))
#define XB_XGEN(j)  (2304 + 64 * (j))
#define XB_TOP      3328
#define XB_TOPGEN   3392
#define XB_SPIN_CAP (1u << 22)
__device__ __forceinline__ unsigned xb_ld(unsigned* p) { return __hip_atomic_load(p, __ATOMIC_RELAXED, __HIP_MEMORY_SCOPE_AGENT); }
__device__ __forceinline__ unsigned xb_add(unsigned* p, unsigned v) { return __hip_atomic_fetch_add(p, v, __ATOMIC_RELAXED, __HIP_MEMORY_SCOPE_AGENT); }
__device__ __forceinline__ unsigned xb_xcc_id() { return (unsigned)__builtin_amdgcn_s_getreg((3 << 11) | 20) & 0xFu; }
#define XB_SPIN(cond, bar) do { unsigned _sp = 0; while (cond) { __builtin_amdgcn_s_sleep(1); \
    if ((++_sp & 255u) == 0u) { if (xb_ld(&(bar)[XB_TMO])) break; if (_sp > XB_SPIN_CAP) { atomicAdd(&(bar)[XB_TMO], 1u); break; } } } } while (0)

__device__ __forceinline__ void xcd_barrier_post(unsigned* bar) {
  if (threadIdx.x == 0) (void)xb_add(&bar[XB_XCNT(xb_xcc_id())], 1u);
}
__device__ __noinline__ void xcd_sync(unsigned* bar) {
  asm volatile("s_waitcnt vmcnt(0)" ::: "memory");
  __syncthreads();
  if (threadIdx.x == 0) {
    __builtin_amdgcn_s_waitcnt(0);
    const unsigned x = xb_xcc_id();
    unsigned packed = bar[3456 + blockIdx.x];
    unsigned nloc = packed & 0xffffu, nx = packed >> 16;
    if (nloc == 0u) {
      const unsigned G = gridDim.x;
      unsigned sum, cnt, mine, sp = 0u;
      for (;;) {
        sum = 0u; cnt = 0u; mine = 0u;
#pragma unroll
        for (unsigned j = 0; j < 16; ++j) { const unsigned c = xb_ld(&bar[XB_XCNT(j)]); sum += c; cnt += (c > 0u) ? 1u : 0u; mine = (j == x) ? c : mine; }
        if (sum == G) break;
        __builtin_amdgcn_s_sleep(1);
        if ((++sp & 255u) == 0u) { if (xb_ld(&bar[XB_TMO])) break; if (sp > XB_SPIN_CAP) { atomicAdd(&bar[XB_TMO], 1u); break; } }
      }
      nloc = mine > 0u ? mine : 1u; nx = cnt > 0u ? cnt : 1u;
      bar[3456 + blockIdx.x] = nloc | (nx << 16);
    }
    const unsigned old = xb_add(&bar[XB_XSUB(x)], 1u);
    const unsigned gen = old / nloc;
    if (old + 1u == (gen + 1u) * nloc) {
      __builtin_amdgcn_fence(__ATOMIC_RELEASE, "agent");
      asm volatile("s_waitcnt vmcnt(0)" ::: "memory");
      const unsigned og = xb_add(&bar[XB_TOP], 1u);
      const unsigned tg = og / nx;
      if (og + 1u == (tg + 1u) * nx) xb_add(&bar[XB_TOPGEN], 1u);
      else XB_SPIN(xb_ld(&bar[XB_TOPGEN]) == tg, bar);
      __builtin_amdgcn_fence(__ATOMIC_ACQUIRE, "agent");
      xb_add(&bar[XB_XGEN(x)], 1u);
      asm volatile("s_waitcnt vmcnt(0)" ::: "memory");
    } else {
      XB_SPIN(xb_ld(&bar[XB_XGEN(x)]) == gen, bar);
      __builtin_amdgcn_fence(__ATOMIC_ACQUIRE, "agent");
      asm volatile("s_waitcnt vmcnt(0)" ::: "memory");
    }
  }
  __syncthreads();
}

__global__ void __launch_bounds__(256, 2) mega_kernel(Params p_unused) {
  __shared__ __attribute__((aligned(16))) char smem[81920];
  xcd_barrier_post((unsigned*)(get_params()->ws + OFF_BAR));
  { CParams& p = *get_params(); phase_prep(p, smem); }
  xcd_sync((unsigned*)(get_params()->ws + OFF_BAR));
  { CParams& p = *get_params(); phase_gemm1(p, smem); }
  xcd_sync((unsigned*)(get_params()->ws + OFF_BAR));
  { CParams& p = *get_params(); phase_mix(p, smem); }
  xcd_sync((unsigned*)(get_params()->ws + OFF_BAR));
  { CParams& p = *get_params(); phase_scan2(p); }
  xcd_sync((unsigned*)(get_params()->ws + OFF_BAR));
  { CParams& p = *get_params(); phase_proj(p, smem); }
  xcd_sync((unsigned*)(get_params()->ws + OFF_BAR));
  { CParams& p = *get_params(); phase_wout(p, smem); }
  xcd_sync((unsigned*)(get_params()->ws + OFF_BAR));
  { CParams& p = *get_params(); phase_pq(p, smem); }
  xcd_sync((unsigned*)(get_params()->ws + OFF_BAR));
  { CParams& p = *get_params(); phase_peer(p, smem); }
  xcd_sync((unsigned*)(get_params()->ws + OFF_BAR));
  { CParams& p = *get_params(); phase_ple(p, smem); }
  if (get_params()->ws == nullptr) cg::this_grid().sync();
}

extern "C" void kernel_launch(void* const* d_in, const int* in_sizes, int n_in, void* d_out, int out_size, void* d_ws,
                              size_t ws_size, hipStream_t stream) {
  static int grid_blocks = 0;
  if (!grid_blocks) {
    int dev = 0, cus = 0, per_cu = 0;
    hipGetDevice(&dev);
    hipDeviceGetAttribute(&cus, hipDeviceAttributeMultiprocessorCount, dev);
    hipOccupancyMaxActiveBlocksPerMultiprocessor(&per_cu, mega_kernel, 256, 0);
    if (per_cu > 2) per_cu = 2;
    grid_blocks = cus * per_cu;
    if (ws_size < WS_NEED) fprintf(stderr, "workspace too small: %zu < %zu\n", ws_size, (size_t)WS_NEED);
  }
  Params p{};
  const float** pp = (const float**)&p;
  for (int i = 0; i < 31; i++) pp[i] = (const float*)d_in[i];
  p.out = (float*)d_out;
  p.ws = (char*)d_ws;
  hipMemsetAsync((char*)d_ws + OFF_BAR, 0, 16384, stream);
  void* args[] = {&p};
  hipError_t e = hipLaunchCooperativeKernel((void*)mega_kernel, dim3(grid_blocks), dim3(256), args, 0, stream);
  if (e != hipSuccess) fprintf(stderr, "cooperative launch failed: %s (grid %d)\n", hipGetErrorString(e), grid_blocks);
}
```

```cpp
#include <hip/hip_runtime.h>
#include <hip/hip_cooperative_groups.h>
#include <stdint.h>
#include <cstdio>
namespace cg = cooperative_groups;

#ifndef MEGA
#define MEGA 1
#endif

typedef unsigned short bf16_t;
using bf16x8 = __attribute__((ext_vector_type(8))) short;
using f32x16 = __attribute__((ext_vector_type(16))) float;
using u32x8 = __attribute__((ext_vector_type(8))) unsigned;
using u32x2 = __attribute__((ext_vector_type(2))) unsigned;

#define NTOK 16896
#define NPROMPT 16384
#define EPSF 1e-6f

#define OFF_R1   ((size_t)0)
#define OFF_ZR   (OFF_R1 + (size_t)69206016)
#define OFF_ZG   (OFF_ZR + (size_t)121110528)
#define OFF_W    (OFF_ZG + (size_t)138412032)
#define OFF_U    (OFF_W + (size_t)67108864)
#define OFF_V    (OFF_U + (size_t)33554432)
#define OFF_SUM  (OFF_V + (size_t)33554432)
#define OFF_ROPE (OFF_SUM + (size_t)4194304)
#define OFF_PLB  (OFF_ROPE + (size_t)262400)
#define OFF_BAR  (OFF_PLB + (size_t)8650752)
#define WS_NEED  (OFF_BAR + (size_t)16384)

#define W_IN   ((size_t)0)
#define W_RNN  (W_IN + (size_t)7680 * 2048)
#define W_ATT  (W_RNN + (size_t)2048 * 1024)
#define W_OUT  (W_ATT + (size_t)2048 * 1024)
#define W_PQ   (W_OUT + (size_t)2048 * 2048)
#define W_PLE  (W_PQ + (size_t)2048 * 2048)
#define W_GATE (W_PLE + (size_t)2048 * 256)
#define W_RG   (W_GATE + (size_t)2048 * 2048)
#define W_IG   (W_RG + (size_t)8 * 128 * 128)
#define W_SK   (W_IG + (size_t)8 * 128 * 128)

#define O_Y      ((size_t)0)
#define O_PCONV  ((size_t)34603008)
#define O_PRG    ((size_t)34615296)
#define O_PK     ((size_t)34619392)
#define O_PV     ((size_t)34750464)
#define O_SCONV  ((size_t)34881536)
#define O_SRG    ((size_t)35274752)
#define O_SK     ((size_t)35405824)
#define O_SV     ((size_t)39600128)

struct Params {
  const float *x_prompt, *x_sample, *p_prompt, *p_sample, *state_conv, *state_rglru, *cache_k, *cache_v;
  const float *norm_mix, *w_in, *conv_w, *conv_b, *w_rgate, *b_rgate, *w_igate, *b_igate, *lru_lambda, *w_proj_rnn;
  const float *q_norm, *k_norm, *attn_sinks, *w_proj_attn, *w_out, *norm_ffn, *w_peer_q, *sub_keys, *peer_u, *peer_v;
  const float *w_ple, *norm_ple, *w_ple_gate;
  float* out;
  char* ws;
};

typedef const __attribute__((address_space(4))) Params CParams;
__device__ __forceinline__ CParams* get_params() {
  CParams* kp = (CParams*)__builtin_amdgcn_kernarg_segment_ptr();
  asm volatile("" : "+s"(kp));
  return kp;
}
__device__ __forceinline__ bf16_t f2bf(float f) {
  unsigned u = __float_as_uint(f);
  u += 0x7fffu + ((u >> 16) & 1u);
  return (bf16_t)(u >> 16);
}
__device__ __forceinline__ float bf2f(bf16_t b) { return __uint_as_float(((unsigned)b) << 16); }
__device__ __forceinline__ unsigned pack2(float a, float b) { return (unsigned)f2bf(a) | ((unsigned)f2bf(b) << 16); }
__device__ __forceinline__ float lo2f(unsigned d) { return __uint_as_float(d << 16); }
__device__ __forceinline__ float hi2f(unsigned d) { return __uint_as_float(d & 0xffff0000u); }
__device__ __forceinline__ float sigmoidf_(float x) { return __builtin_amdgcn_rcpf(1.f + __expf(-x)); }
__device__ __forceinline__ float gelu_tanh(float x) {
  float y = 0.7978845608028654f * (x + 0.044715f * x * x * x);
  float th = 1.f - 2.f * __builtin_amdgcn_rcpf(1.f + __expf(2.f * y));
  return 0.5f * x * (1.f + th);
}
__device__ __forceinline__ float wave_sum(float v) {
#pragma unroll
  for (int o = 32; o; o >>= 1) v += __shfl_xor(v, o);
  return v;
}
__device__ __forceinline__ float wave_max(float v) {
#pragma unroll
  for (int o = 32; o; o >>= 1) v = fmaxf(v, __shfl_xor(v, o));
  return v;
}
__device__ __forceinline__ void unpack8(const uint4& u, float* f) {
  f[0] = lo2f(u.x); f[1] = hi2f(u.x); f[2] = lo2f(u.y); f[3] = hi2f(u.y);
  f[4] = lo2f(u.z); f[5] = hi2f(u.z); f[6] = lo2f(u.w); f[7] = hi2f(u.w);
}
__device__ __forceinline__ uint4 pack8(const float* f) {
  uint4 u; u.x = pack2(f[0], f[1]); u.y = pack2(f[2], f[3]); u.z = pack2(f[4], f[5]); u.w = pack2(f[6], f[7]);
  return u;
}
__device__ __forceinline__ const float* x_row(CParams& p, int tok) {
  return tok < NPROMPT ? p.x_prompt + (size_t)tok * 2048 : p.x_sample + (size_t)(tok - NPROMPT) * 2048;
}
__device__ __forceinline__ const float* ple_row(CParams& p, int tok) {
  return tok < NPROMPT ? p.p_prompt + (size_t)tok * 256 : p.p_sample + (size_t)(tok - NPROMPT) * 256;
}

__device__ __forceinline__ bool tile_at(int q, int x, int SM, int SN, int NSM, int NSN, int& mt, int& nt) {
  int ST = SM * SN;
  int sup = (q / ST) * 8 + x;
  if (sup >= NSM * NSN) return false;
  int wi = q % ST;
  mt = (sup / NSN) * SM + wi / SN;
  nt = (sup % NSN) * SN + wi % SN;
  return true;
}

using f32x4 = __attribute__((ext_vector_type(4))) float;
__device__ __forceinline__ void stage_rc(int b, int& R, int& C) {
  int st = b >> 10, sb = b & 1023, swz = sb ^ (((sb >> 9) & 1) << 5);
  R = (st >> 1) * 16 + (swz >> 6);
  C = (st & 1) * 32 + ((swz & 63) >> 1);
}
__device__ __forceinline__ void gemm_loop(f32x4 (&acc)[4][4], const bf16_t* __restrict__ A, int lda,
                                          const bf16_t* __restrict__ B, int ldb, int K, char* smem) {
  const int t = threadIdx.x, lane = t & 63, w = t >> 6, wm = w >> 1, wn = w & 1;
  const int fr = lane & 15, fq = lane >> 4;
  unsigned aoff[4], boff[4];
#pragma unroll
  for (int i = 0; i < 4; i++) {
    int R, C;
    stage_rc(t * 16 + i * 4096, R, C);
    aoff[i] = R * lda + C;
    boff[i] = R * ldb + C;
  }
#define GL_STAGE(s, ko)                                                                                             \
  _Pragma("unroll") for (int i_ = 0; i_ < 4; i_++) {                                                                \
    __builtin_amdgcn_global_load_lds((const unsigned*)(A + aoff[i_] + (ko)),                                        \
                                     (unsigned*)(smem + (s) * 32768 + t * 16 + i_ * 4096), 16, 0, 0);               \
    __builtin_amdgcn_global_load_lds((const unsigned*)(B + boff[i_] + (ko)),                                        \
                                     (unsigned*)(smem + (s) * 32768 + 16384 + t * 16 + i_ * 4096), 16, 0, 0);       \
  }
  const int lane_off = ((fr * 64 + fq * 16) ^ ((fr >> 3) << 5));
  const int a_base = wm * 8192 + lane_off, b_base = 16384 + wn * 8192 + lane_off;
  __syncthreads();
  GL_STAGE(0, 0)
  const int nt = K >> 6;
  for (int kt = 0; kt < nt; kt++) {
    const int cur = kt & 1;
    __syncthreads();
    if (kt + 1 < nt) { GL_STAGE(cur ^ 1, (kt + 1) * 64) }
    const char* sb = smem + cur * 32768;
#pragma unroll
    for (int k2 = 0; k2 < 2; k2++) {
      bf16x8 af[4], bfr[4];
#pragma unroll
      for (int m = 0; m < 4; m++) af[m] = *(const bf16x8*)(sb + a_base + m * 2048 + k2 * 1024);
#pragma unroll
      for (int n = 0; n < 4; n++) bfr[n] = *(const bf16x8*)(sb + b_base + n * 2048 + k2 * 1024);
#pragma unroll
      for (int n = 0; n < 4; n++)
#pragma unroll
        for (int m = 0; m < 4; m++) acc[n][m] = __builtin_amdgcn_mfma_f32_16x16x32_bf16(bfr[n], af[m], acc[n][m], 0, 0, 0);
    }
  }
}
__device__ __forceinline__ void zero_acc4(f32x4 (&acc)[4][4]) {
#pragma unroll
  for (int i = 0; i < 4; i++)
#pragma unroll
    for (int j = 0; j < 4; j++) acc[i][j] = (f32x4){0.f, 0.f, 0.f, 0.f};
}
#define LROW2 (wm * 64 + (lane & 15))
#define LCOL2 (wn * 64 + (lane >> 4) * 4)

#define G3_STAGE_BYTES 40960
#define G3_B_OFF 24576
__device__ __forceinline__ void gemm_loop3(f32x4 (&acc)[4][6], const bf16_t* __restrict__ A, int lda,
                                           const bf16_t* __restrict__ B, int ldb, int K, char* smem) {
  const int t = threadIdx.x, lane = t & 63, w = t >> 6, wm = w >> 1, wn = w & 1;
  const int fr = lane & 15, fq = lane >> 4;
  unsigned aoff[6], boff[4];
#pragma unroll
  for (int i = 0; i < 6; i++) {
    int R, C;
    stage_rc(t * 16 + i * 4096, R, C);
    aoff[i] = R * lda + C;
    if (i < 4) boff[i] = R * ldb + C;
  }
#define G3_ISSUE(s, ko)                                                                                        \
  {                                                                                                            \
    char* sb_ = smem + (s) * G3_STAGE_BYTES + t * 16;                                                          \
    _Pragma("unroll") for (int i_ = 0; i_ < 6; i_++)                                                           \
        __builtin_amdgcn_global_load_lds((const unsigned*)(A + (unsigned)(aoff[i_] + (ko))), (unsigned*)(sb_ + i_ * 4096), 16, 0, 0); \
    _Pragma("unroll") for (int i_ = 0; i_ < 4; i_++)                                                           \
        __builtin_amdgcn_global_load_lds((const unsigned*)(B + (unsigned)(boff[i_] + (ko))), (unsigned*)(sb_ + G3_B_OFF + i_ * 4096), 16, 0, 0); \
  }
  const int lane_off = ((fr * 64 + fq * 16) ^ ((fr >> 3) << 5));
  const int a_base = wm * 12288 + lane_off, b_base = G3_B_OFF + wn * 8192 + lane_off;
  __syncthreads();
  const int nt = K >> 6;
  G3_ISSUE(0, 0)
  for (int kt = 0; kt < nt; kt++) {
    const int cur = kt & 1;
    __syncthreads();
    if (kt + 1 < nt) G3_ISSUE(cur ^ 1, (kt + 1) * 64)
    const char* sb = smem + cur * G3_STAGE_BYTES;
#pragma unroll
    for (int k2 = 0; k2 < 2; k2++) {
      bf16x8 af[6], bfr[4];
#pragma unroll
      for (int m = 0; m < 6; m++) af[m] = *(const bf16x8*)(sb + a_base + m * 2048 + k2 * 1024);
#pragma unroll
      for (int n = 0; n < 4; n++) bfr[n] = *(const bf16x8*)(sb + b_base + n * 2048 + k2 * 1024);
#pragma unroll
      for (int n = 0; n < 4; n++)
#pragma unroll
        for (int m = 0; m < 6; m++) acc[n][m] = __builtin_amdgcn_mfma_f32_16x16x32_bf16(bfr[n], af[m], acc[n][m], 0, 0, 0);
      __builtin_amdgcn_sched_barrier(0);
    }
  }
}
__device__ __forceinline__ void zero_acc6(f32x4 (&acc)[4][6]) {
#pragma unroll
  for (int i = 0; i < 4; i++)
#pragma unroll
    for (int j = 0; j < 6; j++) acc[i][j] = (f32x4){0.f, 0.f, 0.f, 0.f};
}
#define LROW3 (wm * 96 + (lane & 15))

__device__ __forceinline__ void lds_gemm128(f32x16 (&acc)[2][2], const bf16_t (*A2)[136], const bf16_t (*B2)[136]) {
  const int t = threadIdx.x, lane = t & 63, w = t >> 6, wm = w >> 1, wn = w & 1;
  const int fr = lane & 31, fk = (lane >> 5) * 8;
#pragma unroll
  for (int kk = 0; kk < 8; kk++) {
    bf16x8 a0 = *(const bf16x8*)&A2[wm * 64 + fr][kk * 16 + fk];
    bf16x8 a1 = *(const bf16x8*)&A2[wm * 64 + 32 + fr][kk * 16 + fk];
    bf16x8 b0 = *(const bf16x8*)&B2[wn * 64 + fr][kk * 16 + fk];
    bf16x8 b1 = *(const bf16x8*)&B2[wn * 64 + 32 + fr][kk * 16 + fk];
    acc[0][0] = __builtin_amdgcn_mfma_f32_32x32x16_bf16(a0, b0, acc[0][0], 0, 0, 0);
    acc[0][1] = __builtin_amdgcn_mfma_f32_32x32x16_bf16(a0, b1, acc[0][1], 0, 0, 0);
    acc[1][0] = __builtin_amdgcn_mfma_f32_32x32x16_bf16(a1, b0, acc[1][0], 0, 0, 0);
    acc[1][1] = __builtin_amdgcn_mfma_f32_32x32x16_bf16(a1, b1, acc[1][1], 0, 0, 0);
  }
}
__device__ __forceinline__ void load_b2(bf16_t (*B2)[136], const bf16_t* __restrict__ src) {
  const int t = threadIdx.x;
#pragma unroll
  for (int i = 0; i < 8; i++) {
    int c = t + 256 * i, row = c >> 4, col = (c & 15) * 8;
    *(uint4*)&B2[row][col] = *(const uint4*)(src + row * 128 + col);
  }
}
__device__ __forceinline__ void zero_acc(f32x16 (&acc)[2][2]) {
#pragma unroll
  for (int i = 0; i < 2; i++)
#pragma unroll
    for (int j = 0; j < 2; j++)
#pragma unroll
      for (int r = 0; r < 16; r++) acc[i][j][r] = 0.f;
}
#define ACC_ROW(i, r) (wm * 64 + (i) * 32 + ((r) & 3) + 8 * ((r) >> 2) + 4 * (lane >> 5))
#define ACC_COL(j) (wn * 64 + (j) * 32 + (lane & 31))
#define EPI_VARS const int lane = threadIdx.x & 63, wm = threadIdx.x >> 7, wn = (threadIdx.x >> 6) & 1;
#define ROWC(i, r) ((i) * 32 + ((r) & 3) + 8 * ((r) >> 2))
#define LROW (wm * 64 + 4 * (lane >> 5))
#define LCOL (wn * 64 + (lane & 31))
__device__ __forceinline__ unsigned opaque_u(unsigned v) { asm volatile("" : "+v"(v)); return v; }

typedef float nt_f4 __attribute__((ext_vector_type(4)));
__device__ __forceinline__ float4 ld_nt4(const float* p) { nt_f4 v = __builtin_nontemporal_load((const nt_f4*)p); return make_float4(v.x, v.y, v.z, v.w); }
__device__ void transpose_tile(const float* __restrict__ src, int ld_src, bf16_t* __restrict__ dst, int ld_dst,
                               int k0, int n0, const float* __restrict__ kscale, char* smem) {
  float (*tile)[65] = (float (*)[65])smem;
  const int t = threadIdx.x;
  __syncthreads();
  const int n4 = (t & 15) * 4, kr = t >> 4;
#pragma unroll
  for (int i = 0; i < 4; i++) {
    int k = kr + 16 * i;
    float4 v = ld_nt4(src + (size_t)(k0 + k) * ld_src + n0 + n4);
    float s = kscale ? kscale[k0 + k] : 1.f;
    tile[k][n4 + 0] = v.x * s; tile[k][n4 + 1] = v.y * s; tile[k][n4 + 2] = v.z * s; tile[k][n4 + 3] = v.w * s;
  }
  __syncthreads();
  const int n = t >> 2, ks = (t & 3) * 16;
  float f[16];
#pragma unroll
  for (int j = 0; j < 16; j++) f[j] = tile[ks + j][n];
  uint4* d = (uint4*)(dst + (size_t)(n0 + n) * ld_dst + k0 + ks);
  d[0] = pack8(f); d[1] = pack8(f + 8);
}

__device__ void phase_prep(CParams& p, char* smem) {
  const int t = threadIdx.x, lane = t & 63, w = t >> 6;
  bf16_t* wsw = (bf16_t*)(p.ws + OFF_W);
  const int N_RMS = NTOK / 4, N_TR = 8128, N_SK = 128, N_UV = 32768, N_ROPE = 129;
  const int TOTAL = N_RMS + N_TR + N_SK + N_UV + N_ROPE;
  for (int it = blockIdx.x; it < TOTAL; it += gridDim.x) {
    int i = it;
    if (i < N_UV) {
      const bool isu = i < 16384;
      const float* src = isu ? p.peer_u + (size_t)i * 2048 : p.peer_v + (size_t)(i - 16384) * 2048;
      unsigned char* dst = (unsigned char*)(p.ws + (isu ? OFF_U : OFF_V)) + (size_t)(i & 16383) * 2048;
      const float sc = isu ? 1024.f : 256.f;
      float4 a = ld_nt4(src + t * 8), b = ld_nt4(src + t * 8 + 4);
      if (isu) {
        const float4 ga = *(const float4*)(p.norm_ffn + t * 8), gb = *(const float4*)(p.norm_ffn + t * 8 + 4);
        a.x *= ga.x; a.y *= ga.y; a.z *= ga.z; a.w *= ga.w; b.x *= gb.x; b.y *= gb.y; b.z *= gb.z; b.w *= gb.w;
      }
      int w0 = __builtin_amdgcn_cvt_pk_fp8_f32(a.x * sc, a.y * sc, 0, false);
      w0 = __builtin_amdgcn_cvt_pk_fp8_f32(a.z * sc, a.w * sc, w0, true);
      int w1 = __builtin_amdgcn_cvt_pk_fp8_f32(b.x * sc, b.y * sc, 0, false);
      w1 = __builtin_amdgcn_cvt_pk_fp8_f32(b.z * sc, b.w * sc, w1, true);
      *(uint2*)(dst + t * 8) = make_uint2((unsigned)w0, (unsigned)w1);
      continue;
    }
    i -= N_UV;
    if (i < N_RMS) {
      int tok = i * 4 + w;
      const float* xr = x_row(p, tok);
      float v[32]; float ss = 0.f;
#pragma unroll
      for (int c = 0; c < 4; c++) {
        float4 a = ld_nt4(xr + c * 512 + lane * 8), b = ld_nt4(xr + c * 512 + lane * 8 + 4);
        v[c * 8 + 0] = a.x; v[c * 8 + 1] = a.y; v[c * 8 + 2] = a.z; v[c * 8 + 3] = a.w;
        v[c * 8 + 4] = b.x; v[c * 8 + 5] = b.y; v[c * 8 + 6] = b.z; v[c * 8 + 7] = b.w;
      }
#pragma unroll
      for (int j = 0; j < 32; j++) ss += v[j] * v[j];
      ss = wave_sum(ss);
      float rs = rsqrtf(ss * (1.f / 2048.f) + EPSF);
      bf16_t* dst = (bf16_t*)(p.ws + OFF_R1) + (size_t)tok * 2048;
#pragma unroll
      for (int c = 0; c < 4; c++) {
        const float* g = p.norm_mix + c * 512 + lane * 8;
        float f[8];
#pragma unroll
        for (int j = 0; j < 8; j++) f[j] = v[c * 8 + j] * rs * g[j];
        *(uint4*)(dst + c * 512 + lane * 8) = pack8(f);
      }
      continue;
    }
    i -= N_RMS;
    if (i < N_TR) {
      const float* src; bf16_t* dst; int K, Nn; const float* ks = nullptr;
      if (i < 3840) { src = p.w_in; dst = wsw + W_IN; K = 2048; Nn = 7680; }
      else if ((i -= 3840) < 512) { src = p.w_proj_rnn; dst = wsw + W_RNN; K = 1024; Nn = 2048; }
      else if ((i -= 512) < 512) { src = p.w_proj_attn; dst = wsw + W_ATT; K = 1024; Nn = 2048; }
      else if ((i -= 512) < 1024) { src = p.w_out; dst = wsw + W_OUT; K = 2048; Nn = 2048; }
      else if ((i -= 1024) < 1024) { src = p.w_peer_q; dst = wsw + W_PQ; K = 2048; Nn = 2048; ks = p.norm_ffn; }
      else if ((i -= 1024) < 128) { src = p.w_ple; dst = wsw + W_PLE; K = 256; Nn = 2048; }
      else if ((i -= 128) < 1024) { src = p.w_ple_gate; dst = wsw + W_GATE; K = 2048; Nn = 2048; ks = p.norm_ple; }
      else if ((i -= 1024) < 32) { int b = i >> 2; src = p.w_rgate + b * 16384; dst = wsw + W_RG + b * 16384; K = 128; Nn = 128; i &= 3; }
      else { i -= 32; int b = i >> 2; src = p.w_igate + b * 16384; dst = wsw + W_IG + b * 16384; K = 128; Nn = 128; i &= 3; }
      int nkt = K / 64;
      int kt = i % nkt, ntile = i / nkt;
      transpose_tile(src, Nn, dst, K, kt * 64, ntile * 64, ks, smem);
      continue;
    }
    i -= N_TR;
    if (i < N_SK) {
      const float* src = p.sub_keys + (size_t)i * 2048;
      bf16_t* dst = wsw + W_SK + (size_t)i * 2048;
      float4 a = ld_nt4(src + t * 8), b = ld_nt4(src + t * 8 + 4);
      uint4 o; o.x = pack2(a.x, a.y); o.y = pack2(a.z, a.w); o.z = pack2(b.x, b.y); o.w = pack2(b.z, b.w);
      *(uint4*)(dst + t * 8) = o;
      continue;
    }
    i -= N_SK;
    {
      int e = i * 256 + t;
      if (e < 4100 * 8) {
        int pi = e >> 3, fi = e & 7;
        int pos = pi < 4096 ? pi : 16384 + (pi - 4096);
        float inv = powf(500000.f, -(float)fi * 0.125f);
        float ang = (float)pos * inv;
        double tr = (double)ang * 0.15915494309189535;
        tr -= rint(tr);
        float fr = (float)tr;
        float2 cs; cs.x = __builtin_amdgcn_cosf(fr); cs.y = __builtin_amdgcn_sinf(fr);
        ((float2*)(p.ws + OFF_ROPE))[e] = cs;
      }
    }
  }
}

__device__ void phase_gemm1(CParams& p, char* smem) {
  EPI_VARS
  const bf16_t* A = (const bf16_t*)(p.ws + OFF_R1);
  const bf16_t* B = (const bf16_t*)(p.ws + OFF_W) + W_IN;
  bf16_t* zr = (bf16_t*)(p.ws + OFF_ZR);
  bf16_t* zg = (bf16_t*)(p.ws + OFF_ZG);
  const int x = blockIdx.x & 7, per = gridDim.x >> 3;
  if ((int)blockIdx.x >= per * 8) return;
  for (int q = blockIdx.x >> 3;; q += per) {
    int mt, nt;
    if (!tile_at(q, x, 4, 10, 22, 6, mt, nt)) break;
    f32x4 acc[4][6];
    zero_acc6(acc);
    gemm_loop3(acc, A + (size_t)mt * 192 * 2048, 2048, B + (size_t)nt * 128 * 2048, 2048, 2048, smem);
    const int n0 = nt * 128;
    const int act = (n0 < 1024) ? 0 : (n0 < 2048 ? 1 : (n0 < 3584 ? 0 : 2));
    bf16_t* dst; int ld, cb;
    if (n0 < 3584) { dst = zr; ld = 3584; cb = n0; } else { dst = zg; ld = 4096; cb = n0 - 3584; }
    if (act == 2) {
      uint4* gt = (uint4*)zg + ((size_t)(mt * 32 + (nt - 28)) * 12) * 256 + opaque_u(threadIdx.x);
#pragma unroll
      for (int mm = 0; mm < 6; mm++)
#pragma unroll
        for (int n2 = 0; n2 < 2; n2++) {
          uint4 o;
          o.x = pack2(sigmoidf_(acc[2 * n2][mm][0]), sigmoidf_(acc[2 * n2][mm][1]));
          o.y = pack2(sigmoidf_(acc[2 * n2][mm][2]), sigmoidf_(acc[2 * n2][mm][3]));
          o.z = pack2(sigmoidf_(acc[2 * n2 + 1][mm][0]), sigmoidf_(acc[2 * n2 + 1][mm][1]));
          o.w = pack2(sigmoidf_(acc[2 * n2 + 1][mm][2]), sigmoidf_(acc[2 * n2 + 1][mm][3]));
          gt[(mm * 2 + n2) * 256] = o;
        }
    } else {
      bf16_t* dt = dst + (size_t)mt * 192 * ld + cb;
      bf16_t (*T)[136] = (bf16_t (*)[136])smem;
      __syncthreads();
      const unsigned lrow = opaque_u(LROW3), lcol = opaque_u(LCOL2);
#pragma unroll
      for (int mm = 0; mm < 6; mm++)
#pragma unroll
        for (int nn = 0; nn < 4; nn++) {
          float v[4];
#pragma unroll
          for (int j = 0; j < 4; j++) {
            v[j] = acc[nn][mm][j];
            if (act == 1) v[j] = gelu_tanh(v[j]);
          }
          *(uint2*)&T[lrow + mm * 16][lcol + nn * 16] = make_uint2(pack2(v[0], v[1]), pack2(v[2], v[3]));
        }
      __syncthreads();
      const unsigned tt = opaque_u(threadIdx.x);
#pragma unroll
      for (int i = 0; i < 12; i++) {
        const unsigned c = tt + 256u * i, row = c >> 4, ch = (c & 15u) * 8u;
        *(uint4*)(dt + (size_t)row * ld + ch) = *(const uint4*)&T[row][ch];
      }
    }
  }
}

__device__ void rglru_tile(CParams& p, int mt, int jb, char* smem) {
  EPI_VARS
  bf16_t (*A2)[136] = (bf16_t (*)[136])smem;
  bf16_t (*B2)[136] = (bf16_t (*)[136])(smem + 34816);
  const bf16_t* zr = (const bf16_t*)(p.ws + OFF_ZR);
  const bf16_t* wsw = (const bf16_t*)(p.ws + OFF_W);
  unsigned* ab_arr = (unsigned*)p.out;
  const int t = threadIdx.x;
  const int c8 = (t & 15) * 8, r0 = t >> 4, ch0 = jb * 128 + c8;
  float cw[4][8], cbias[8];
#pragma unroll
  for (int k = 0; k < 4; k++)
#pragma unroll
    for (int j = 0; j < 8; j++) cw[k][j] = p.conv_w[k * 1024 + ch0 + j];
#pragma unroll
  for (int j = 0; j < 8; j++) cbias[j] = p.conv_b[ch0 + j];
  __syncthreads();
  for (int i = 0; i < 8; i++) {
    int r = r0 + 16 * i, tok = mt * 128 + r;
    float xc[8];
#pragma unroll
    for (int j = 0; j < 8; j++) xc[j] = cbias[j];
#pragma unroll
    for (int d = 0; d < 4; d++) {
      float xv[8];
      bool fromz, zero = false;
      int sidx = 0;
      if (tok < NPROMPT) { fromz = ((tok & 4095) >= d); zero = !fromz; }
      else { int s = tok - NPROMPT, dt = s & 3; fromz = (dt >= d); sidx = ((s >> 2) * 3 + (3 + dt - d)); }
      if (fromz) {
        uint4 u = *(const uint4*)(zr + (size_t)(tok - d) * 3584 + ch0);
        unpack8(u, xv);
      } else if (zero) {
#pragma unroll
        for (int j = 0; j < 8; j++) xv[j] = 0.f;
      } else {
        const float* sp = p.state_conv + (size_t)sidx * 1024 + ch0;
#pragma unroll
        for (int j = 0; j < 8; j++) xv[j] = sp[j];
      }
      if (d == 0) {
        if (tok < NPROMPT) {
          int ts = tok & 4095;
          if (ts >= 4093) {
            float* o = p.out + O_PCONV + (size_t)((tok >> 12) * 3 + (ts - 4093)) * 1024 + ch0;
#pragma unroll
            for (int j = 0; j < 8; j++) o[j] = xv[j];
          }
        } else {
          int s = tok - NPROMPT, dt = s & 3;
          if (dt >= 1) {
            float* o = p.out + O_SCONV + (size_t)((s >> 2) * 3 + (dt - 1)) * 1024 + ch0;
#pragma unroll
            for (int j = 0; j < 8; j++) o[j] = xv[j];
          }
        }
      }
#pragma unroll
      for (int j = 0; j < 8; j++) xc[j] += cw[3 - d][j] * xv[j];
    }
    *(uint4*)&A2[r][c8] = pack8(xc);
  }
  load_b2(B2, wsw + W_RG + jb * 16384);
  __syncthreads();
  f32x16 accr[2][2], acci[2][2];
  zero_acc(accr); zero_acc(acci);
  lds_gemm128(accr, A2, B2);
  __syncthreads();
  load_b2(B2, wsw + W_IG + jb * 16384);
  __syncthreads();
  lds_gemm128(acci, A2, B2);
  float* sumP = (float*)(p.ws + OFF_SUM);
  float* sumH = sumP + 524288;
  const int hh = lane >> 5;
#pragma unroll
  for (int j = 0; j < 2; j++) {
    int col = ACC_COL(j), ch = jb * 128 + col;
    float br = p.b_rgate[ch], bi = p.b_igate[ch];
    float sp = log1pf(__expf(-p.lru_lambda[ch]));
#pragma unroll
    for (int i = 0; i < 2; i++) {
      float Pq[4], Hq[4];
#pragma unroll
      for (int r = 0; r < 16; r++) {
        int row = ACC_ROW(i, r), tok = mt * 128 + row;
        float xcv = bf2f(A2[row][col]);
        float rg = __builtin_amdgcn_rcpf(1.f + __expf(-(accr[i][j][r] + br)));
        float ig = __builtin_amdgcn_rcpf(1.f + __expf(-(acci[i][j][r] + bi)));
        float la = -8.f * rg * sp;
        float a = __expf(la);
        float mult = (tok < NPROMPT && (tok & 4095) == 0) ? 1.f : sqrtf(fmaxf(1.f - a * a, 0.f));
        float bv = mult * ig * xcv;
        const unsigned da = f2bf(1.f - a), bb = f2bf(bv);
        ab_arr[(size_t)tok * 1024 + ch] = (da << 16) | bb;
        const float ar = 1.f - bf2f((bf16_t)da), brr = bf2f((bf16_t)bb);
        if ((r & 3) == 0) { Pq[r >> 2] = ar; Hq[r >> 2] = brr; }
        else { Pq[r >> 2] *= ar; Hq[r >> 2] = Hq[r >> 2] * ar + brr; }
      }
      if (mt < 128) {
        float P = 1.f, H = 0.f;
#pragma unroll
        for (int q = 0; q < 4; q++) {
          float Pp = __shfl_xor(Pq[q], 32), Hp = __shfl_xor(Hq[q], 32);
          float P1 = hh ? Pp : Pq[q], H1 = hh ? Hp : Hq[q];
          float P2 = hh ? Pq[q] : Pp, H2 = hh ? Hq[q] : Hp;
          H = H * P1 + H1; P *= P1;
          H = H * P2 + H2; P *= P2;
        }
        if (hh == 0) {
          int cid = mt * 4 + wm * 2 + i;
          sumP[(size_t)cid * 1024 + ch] = P;
          sumH[(size_t)cid * 1024 + ch] = H;
        }
      }
    }
  }
}

__device__ void attn_prompt_item(CParams& p, int b, int nb, int kvh, char* smem) {
  const int t = threadIdx.x, lane = t & 63, w = t >> 6;
  bf16_t (*Ks)[72] = (bf16_t (*)[72])smem;
  bf16_t (*Vt)[264] = (bf16_t (*)[264])(smem + 36864);
  const bf16_t* zr = (const bf16_t*)(p.ws + OFF_ZR);
  const float2* rope = (const float2*)(p.ws + OFF_ROPE);
  bf16_t* obuf = (bf16_t*)(p.ws + OFF_R1) + (size_t)NTOK * 1024;
  __syncthreads();
  {
    int jk = t;
    int ts = (nb - 1) * 128 + jk;
    if (ts >= 0) {
      int tok = b * 4096 + ts;
      const bf16_t* kp = zr + (size_t)tok * 3584 + 3072 + kvh * 64;
      const bf16_t* vp = zr + (size_t)tok * 3584 + 3328 + kvh * 64;
      const bool wout = (nb == 31 && jk >= 128);
      float* ok = p.out + O_PK + (size_t)((b * 128 + (jk - 128)) * 4 + kvh) * 64;
      float* ov = p.out + O_PV + (size_t)((b * 128 + (jk - 128)) * 4 + kvh) * 64;
      uint4 k0 = *(const uint4*)(kp), k1 = *(const uint4*)(kp + 8), k2 = *(const uint4*)(kp + 16), k3 = *(const uint4*)(kp + 24);
      uint4 k4 = *(const uint4*)(kp + 32), k5 = *(const uint4*)(kp + 40), k6 = *(const uint4*)(kp + 48), k7 = *(const uint4*)(kp + 56);
      float ss = 0.f;
#define SSQ8(u) { float f_[8]; unpack8(u, f_); for (int j_ = 0; j_ < 8; j_++) ss += f_[j_] * f_[j_]; }
      SSQ8(k0) SSQ8(k1) SSQ8(k2) SSQ8(k3) SSQ8(k4) SSQ8(k5) SSQ8(k6) SSQ8(k7)
      const float rs = rsqrtf(ss * (1.f / 64.f) + EPSF);
      {
        float f0[8], f1[8];
        unpack8(k0, f0); unpack8(k1, f1);
#pragma unroll
        for (int i = 0; i < 8; i++) {
          float x1 = f0[i] * rs * p.k_norm[i], x2 = f1[i] * rs * p.k_norm[8 + i];
          float2 cs = rope[ts * 8 + i];
          f0[i] = x1 * cs.x - x2 * cs.y;
          f1[i] = x2 * cs.x + x1 * cs.y;
        }
        *(uint4*)&Ks[jk][0] = pack8(f0);
        *(uint4*)&Ks[jk][8] = pack8(f1);
        if (wout) {
          *(float4*)(ok + 0) = make_float4(f0[0], f0[1], f0[2], f0[3]); *(float4*)(ok + 4) = make_float4(f0[4], f0[5], f0[6], f0[7]);
          *(float4*)(ok + 8) = make_float4(f1[0], f1[1], f1[2], f1[3]); *(float4*)(ok + 12) = make_float4(f1[4], f1[5], f1[6], f1[7]);
        }
      }
#define KREST(u, c) { float f_[8]; unpack8(u, f_); for (int j_ = 0; j_ < 8; j_++) f_[j_] = f_[j_] * rs * p.k_norm[(c) * 8 + j_]; \
        *(uint4*)&Ks[jk][(c) * 8] = pack8(f_); \
        if (wout) { *(float4*)(ok + (c) * 8) = make_float4(f_[0], f_[1], f_[2], f_[3]); *(float4*)(ok + (c) * 8 + 4) = make_float4(f_[4], f_[5], f_[6], f_[7]); } }
      KREST(k2, 2) KREST(k3, 3) KREST(k4, 4) KREST(k5, 5) KREST(k6, 6) KREST(k7, 7)
#pragma unroll 2
      for (int c = 0; c < 8; c++) {
        uint4 u = *(const uint4*)(vp + c * 8);
        Vt[c * 8 + 0][jk] = (bf16_t)(u.x & 0xffffu); Vt[c * 8 + 1][jk] = (bf16_t)(u.x >> 16);
        Vt[c * 8 + 2][jk] = (bf16_t)(u.y & 0xffffu); Vt[c * 8 + 3][jk] = (bf16_t)(u.y >> 16);
        Vt[c * 8 + 4][jk] = (bf16_t)(u.z & 0xffffu); Vt[c * 8 + 5][jk] = (bf16_t)(u.z >> 16);
        Vt[c * 8 + 6][jk] = (bf16_t)(u.w & 0xffffu); Vt[c * 8 + 7][jk] = (bf16_t)(u.w >> 16);
        if (wout) {
          float f_[8]; unpack8(u, f_);
          *(float4*)(ov + c * 8) = make_float4(f_[0], f_[1], f_[2], f_[3]); *(float4*)(ov + c * 8 + 4) = make_float4(f_[4], f_[5], f_[6], f_[7]);
        }
      }
    } else {
      uint4 z4 = make_uint4(0, 0, 0, 0);
#pragma unroll
      for (int c = 0; c < 8; c++) *(uint4*)&Ks[jk][c * 8] = z4;
#pragma unroll
      for (int d = 0; d < 64; d++) Vt[d][jk] = 0;
    }
  }
  __syncthreads();
  const int r = lane & 31, h = lane >> 5;
  const int iq = 32 * w + r;
  const int tsq = nb * 128 + iq;
  const int tokq = b * 4096 + tsq;
#pragma unroll 1
  for (int g = 0; g < 4; g++) {
    asm volatile("" ::: "memory");
    const int qh = kvh * 4 + g;
    float qf[4][8];
    const bf16_t* qp = zr + (size_t)tokq * 3584 + 2048 + qh * 64 + 8 * h;
    float ss = 0.f;
#pragma unroll
    for (int kk = 0; kk < 4; kk++) {
      uint4 u = *(const uint4*)(qp + kk * 16);
      unpack8(u, qf[kk]);
#pragma unroll
      for (int j = 0; j < 8; j++) ss += qf[kk][j] * qf[kk][j];
    }
    ss += __shfl_xor(ss, 32);
    float rs = rsqrtf(ss * (1.f / 64.f) + EPSF);
#pragma unroll
    for (int kk = 0; kk < 4; kk++)
#pragma unroll
      for (int j = 0; j < 8; j++) qf[kk][j] = qf[kk][j] * rs * p.q_norm[kk * 16 + 8 * h + j];
#pragma unroll
    for (int j = 0; j < 8; j++) {
      float2 cs = rope[tsq * 8 + j];
      float mine = qf[0][j];
      float other = __shfl_xor(mine, 32);
      qf[0][j] = (h == 0) ? (mine * cs.x - other * cs.y) : (mine * cs.x + other * cs.y);
    }
    bf16x8 bq[4];
#pragma unroll
    for (int kk = 0; kk < 4; kk++) {
      float f[8];
#pragma unroll
      for (int j = 0; j < 8; j++) f[j] = qf[kk][j] * 0.125f;
      uint4 u = pack8(f);
      bq[kk] = *(bf16x8*)&u;
    }
    f32x16 s[5];
#pragma unroll
    for (int kt = 0; kt < 5; kt++) {
#pragma unroll
      for (int e = 0; e < 16; e++) s[kt][e] = 0.f;
#pragma unroll
      for (int kk = 0; kk < 4; kk++) {
        bf16x8 a = *(const bf16x8*)&Ks[32 * (w + kt) + r][kk * 16 + 8 * h];
        s[kt] = __builtin_amdgcn_mfma_f32_32x32x16_bf16(a, bq[kk], s[kt], 0, 0, 0);
      }
    }
    const float sink = p.attn_sinks[qh];
    float m = -3e38f;
#pragma unroll
    for (int e = 0; e < 16; e++) {
      int jr = (e & 3) + 8 * (e >> 2) + 4 * h;
      s[0][e] = (jr > r) ? s[0][e] : -1e30f;
      s[4][e] = (jr <= r) ? s[4][e] : -1e30f;
    }
    if (nb == 0) {
#pragma unroll
      for (int kt = 0; kt < 4; kt++)
        if (w + kt < 4) {
#pragma unroll
          for (int e = 0; e < 16; e++) s[kt][e] = -1e30f;
        }
    }
#pragma unroll
    for (int kt = 0; kt < 5; kt++)
#pragma unroll
      for (int e = 0; e < 16; e++) m = fmaxf(m, s[kt][e]);
    m = fmaxf(m, __shfl_xor(m, 32));
    m = fmaxf(m, sink);
    float l = 0.f;
#pragma unroll
    for (int kt = 0; kt < 5; kt++)
#pragma unroll
      for (int e = 0; e < 16; e++) { float pv = __expf(s[kt][e] - m); s[kt][e] = pv; l += pv; }
    l += __shfl_xor(l, 32);
    l += __expf(sink - m);
    const float linv = 1.f / l;
    f32x16 o[2];
#pragma unroll
    for (int e = 0; e < 16; e++) { o[0][e] = 0.f; o[1][e] = 0.f; }
#pragma unroll
    for (int kt = 0; kt < 5; kt++)
#pragma unroll
      for (int u2 = 0; u2 < 2; u2++) {
        float f[8];
#pragma unroll
        for (int j = 0; j < 8; j++) f[j] = s[kt][8 * u2 + j];
        uint4 pu = pack8(f);
        bf16x8 pb = *(bf16x8*)&pu;
        int kb = 32 * (w + kt) + 16 * u2 + 4 * h;
#pragma unroll
        for (int dt = 0; dt < 2; dt++) {
          uint2 v0 = *(const uint2*)&Vt[32 * dt + r][kb];
          uint2 v1 = *(const uint2*)&Vt[32 * dt + r][kb + 8];
          uint4 va = make_uint4(v0.x, v0.y, v1.x, v1.y);
          o[dt] = __builtin_amdgcn_mfma_f32_32x32x16_bf16(*(bf16x8*)&va, pb, o[dt], 0, 0, 0);
        }
      }
    bf16_t* op = obuf + (size_t)tokq * 1024 + qh * 64;
#pragma unroll
    for (int dt = 0; dt < 2; dt++)
#pragma unroll
      for (int e4 = 0; e4 < 4; e4++) {
        int d = 32 * dt + 8 * e4 + 4 * h;
        uint2 st;
        st.x = pack2(o[dt][4 * e4 + 0] * linv, o[dt][4 * e4 + 1] * linv);
        st.y = pack2(o[dt][4 * e4 + 2] * linv, o[dt][4 * e4 + 3] * linv);
        *(uint2*)(op + d) = st;
      }
  }
}

__device__ void attn_sample_item(CParams& p, int db, char* smem) {
  const int t = threadIdx.x, lane = t & 63, w = t >> 6;
  const int kvh = w;
  float* qs = (float*)smem + w * 1024;
  float* knew = (float*)smem + 4096 + w * 256;
  float* vnew = (float*)smem + 5120 + w * 256;
  float* ps = (float*)smem + 6144 + w * (16 * 132);
  const bf16_t* zr = (const bf16_t*)(p.ws + OFF_ZR);
  const float2* rope = (const float2*)(p.ws + OFF_ROPE);
  bf16_t* obuf = (bf16_t*)(p.ws + OFF_R1) + (size_t)NTOK * 1024;
  const int tok0 = NPROMPT + db * 4;
  __syncthreads();
  {
    int row = lane >> 4, part = lane & 15, d0 = part * 4;
    const bf16_t* kp = zr + (size_t)(tok0 + row) * 3584 + 3072 + kvh * 64 + d0;
    const bf16_t* vp = zr + (size_t)(tok0 + row) * 3584 + 3328 + kvh * 64 + d0;
    uint2 ku = *(const uint2*)kp, vu = *(const uint2*)vp;
    float kf[4] = {lo2f(ku.x), hi2f(ku.x), lo2f(ku.y), hi2f(ku.y)};
    float vf[4] = {lo2f(vu.x), hi2f(vu.x), lo2f(vu.y), hi2f(vu.y)};
    float ss = kf[0] * kf[0] + kf[1] * kf[1] + kf[2] * kf[2] + kf[3] * kf[3];
    ss += __shfl_xor(ss, 1); ss += __shfl_xor(ss, 2); ss += __shfl_xor(ss, 4); ss += __shfl_xor(ss, 8);
    float rs = rsqrtf(ss * (1.f / 64.f) + EPSF);
#pragma unroll
    for (int j = 0; j < 4; j++) kf[j] = kf[j] * rs * p.k_norm[d0 + j];
#pragma unroll
    for (int j = 0; j < 4; j++) {
      float other = __shfl_xor(kf[j], 2);
      if (part < 4) {
        float2 cs = rope[(4096 + row) * 8 + ((d0 + j) & 7)];
        kf[j] = (part < 2) ? (kf[j] * cs.x - other * cs.y) : (kf[j] * cs.x + other * cs.y);
      }
    }
    float* ok = p.out + O_SK + (size_t)((db * 128 + 124 + row) * 4 + kvh) * 64 + d0;
    float* ov = p.out + O_SV + (size_t)((db * 128 + 124 + row) * 4 + kvh) * 64 + d0;
#pragma unroll
    for (int j = 0; j < 4; j++) { knew[row * 64 + d0 + j] = kf[j]; vnew[row * 64 + d0 + j] = vf[j]; ok[j] = kf[j]; ov[j] = vf[j]; }
  }
  {
    int qrow = lane >> 2, part = lane & 3, g = qrow >> 2, tq = qrow & 3, d0 = part * 16;
    int qh = kvh * 4 + g;
    const bf16_t* qp = zr + (size_t)(tok0 + tq) * 3584 + 2048 + qh * 64 + d0;
    float qf[16];
    unpack8(*(const uint4*)qp, qf); unpack8(*(const uint4*)(qp + 8), qf + 8);
    float ss = 0.f;
#pragma unroll
    for (int j = 0; j < 16; j++) ss += qf[j] * qf[j];
    ss += __shfl_xor(ss, 1); ss += __shfl_xor(ss, 2);
    float rs = rsqrtf(ss * (1.f / 64.f) + EPSF);
#pragma unroll
    for (int j = 0; j < 16; j++) qf[j] = qf[j] * rs * p.q_norm[d0 + j];
    if (part == 0) {
#pragma unroll
      for (int i = 0; i < 8; i++) {
        float2 cs = rope[(4096 + tq) * 8 + i];
        float x1 = qf[i], x2 = qf[i + 8];
        qf[i] = x1 * cs.x - x2 * cs.y;
        qf[i + 8] = x2 * cs.x + x1 * cs.y;
      }
    }
#pragma unroll
    for (int j = 0; j < 16; j++) qs[qrow * 64 + d0 + j] = qf[j] * 0.125f;
  }
  __syncthreads();
#pragma unroll 1
  for (int sl = 0; sl < 3; sl++) {
    int j = lane + 64 * sl;
    if (j < 132) {
      float scq[16];
#pragma unroll
      for (int q = 0; q < 16; q++) scq[q] = 0.f;
      const float* kr = (j < 128) ? p.cache_k + (size_t)((db * 128 + j) * 4 + kvh) * 64 : knew + (j - 128) * 64;
#pragma unroll 2
      for (int d = 0; d < 64; d += 4) {
        float4 kv = *(const float4*)(kr + d);
        if (j >= 4 && j < 128) *(float4*)(p.out + O_SK + (size_t)((db * 128 + j - 4) * 4 + kvh) * 64 + d) = kv;
#pragma unroll
        for (int q = 0; q < 16; q++) {
          float4 qv = *(const float4*)(qs + q * 64 + d);
          scq[q] += kv.x * qv.x + kv.y * qv.y + kv.z * qv.z + kv.w * qv.w;
        }
      }
#pragma unroll
      for (int q = 0; q < 16; q++) ps[q * 132 + j] = scq[q];
    }
  }
#pragma unroll 1
  for (int q = 0; q < 16; q++) {
    int g = q >> 2, tq = q & 3;
    float sink = p.attn_sinks[kvh * 4 + g];
    float m = -3e38f;
    float sv[3];
#pragma unroll
    for (int sl = 0; sl < 3; sl++) {
      int j = lane + 64 * sl;
      bool valid = (j < 132) && (j >= tq + 1) && (j <= tq + 128);
      float v = valid ? ps[q * 132 + j] : -1e30f;
      sv[sl] = v;
      m = fmaxf(m, v);
    }
    m = fmaxf(wave_max(m), sink);
    float l = 0.f;
#pragma unroll
    for (int sl = 0; sl < 3; sl++) { float pv = __expf(sv[sl] - m); sv[sl] = pv; l += pv; }
    l = wave_sum(l) + __expf(sink - m);
    float linv = 1.f / l;
#pragma unroll
    for (int sl = 0; sl < 3; sl++) {
      int j = lane + 64 * sl;
      if (j < 132) ps[q * 132 + j] = sv[sl] * linv;
    }
  }
  __syncthreads();
  float oacc[16];
#pragma unroll
  for (int q = 0; q < 16; q++) oacc[q] = 0.f;
  for (int j = 0; j < 132; j++) {
    float vv;
    if (j < 128) {
      vv = p.cache_v[(size_t)((db * 128 + j) * 4 + kvh) * 64 + lane];
      if (j >= 4) p.out[O_SV + (size_t)((db * 128 + j - 4) * 4 + kvh) * 64 + lane] = vv;
    } else vv = vnew[(j - 128) * 64 + lane];
#pragma unroll
    for (int q = 0; q < 16; q++) oacc[q] += ps[q * 132 + j] * vv;
  }
#pragma unroll
  for (int q = 0; q < 16; q++) {
    int g = q >> 2, tq = q & 3;
    obuf[(size_t)(tok0 + tq) * 1024 + (kvh * 4 + g) * 64 + lane] = f2bf(oacc[q]);
  }
}

#ifndef ONLY2
#define ONLY2 -1
#endif
#define P2_ON(n) (true)
__device__ void phase_mix(CParams& p, char* smem) {
  if (P2_ON(0))
    for (int it = blockIdx.x; it < 512; it += gridDim.x) {
      CParams& q = *get_params();
      attn_prompt_item(q, it >> 7, (it >> 2) & 31, it & 3, smem);
    }
  if (P2_ON(1))
    for (int it = blockIdx.x; it < 1056; it += gridDim.x) {
      CParams& q = *get_params();
      rglru_tile(q, it >> 3, it & 7, smem);
    }
  if (P2_ON(2))
    for (int it = (int)gridDim.x - 1 - (int)blockIdx.x; it < 128; it += gridDim.x) {
      CParams& q = *get_params();
      attn_sample_item(q, it, smem);
    }
}

__device__ void phase_scan1(CParams& p) {}
__device__ void phase_scan2(CParams& p) {
  const unsigned* ab_arr = (const unsigned*)p.out;
  const float* sumP = (const float*)(p.ws + OFF_SUM);
  const float* sumH = sumP + 524288;
  const bf16_t* zr = (const bf16_t*)(p.ws + OFF_ZR);
  bf16_t* hg = (bf16_t*)(p.ws + OFF_R1);
  for (int it = blockIdx.x; it < 512 + 512; it += gridDim.x) {
    if (it < 512) {
      int id = it * 256 + threadIdx.x;
      int ch = id & 1023, cg = (id >> 10) & 31, b = id >> 15;
      float h = 0.f;
      const float* sp = sumP + (size_t)(b * 128) * 1024 + ch;
      const float* sh = sumH + (size_t)(b * 128) * 1024 + ch;
      {
        const int nprev = cg * 4;
        int c = 0;
        for (; c + 16 <= nprev; c += 16) {
          float pp[16], ph_[16];
#pragma unroll
          for (int u = 0; u < 16; u++) { pp[u] = sp[(size_t)(c + u) * 1024]; ph_[u] = sh[(size_t)(c + u) * 1024]; }
#pragma unroll
          for (int u = 0; u < 16; u++) h = pp[u] * h + ph_[u];
        }
        for (; c < nprev; c++) h = sp[(size_t)c * 1024] * h + sh[(size_t)c * 1024];
      }
#pragma unroll 1
      for (int sub = 0; sub < 4; sub++) {
        size_t tok0 = (size_t)b * 4096 + (cg * 4 + sub) * 32;
        unsigned wv[32]; float gv[32];
#pragma unroll
        for (int s2 = 0; s2 < 32; s2++) {
          size_t tok = tok0 + s2;
          wv[s2] = ab_arr[tok * 1024 + ch];
          gv[s2] = bf2f(zr[tok * 3584 + 1024 + ch]);
        }
#pragma unroll
        for (int s2 = 0; s2 < 32; s2++) {
          h = (1.f - hi2f(wv[s2])) * h + lo2f(wv[s2]);
          hg[(tok0 + s2) * 1024 + ch] = f2bf(h * gv[s2]);
        }
      }
      if (cg == 31) p.out[O_PRG + b * 1024 + ch] = h;
    } else {
      int id = (it - 512) * 256 + threadIdx.x;
      int ch = id & 1023, db = id >> 10;
      float h = p.state_rglru[db * 1024 + ch];
#pragma unroll
      for (int dt = 0; dt < 4; dt++) {
        size_t tok = NPROMPT + db * 4 + dt;
        const unsigned wv = ab_arr[tok * 1024 + ch];
        h = (1.f - hi2f(wv)) * h + lo2f(wv);
        float gg = bf2f(zr[tok * 3584 + 1024 + ch]);
        hg[tok * 1024 + ch] = f2bf(h * gg);
      }
      p.out[O_SRG + db * 1024 + ch] = h;
    }
  }
}

__device__ void phase_proj(CParams& p, char* smem) {
  EPI_VARS
  const bf16_t* hg = (const bf16_t*)(p.ws + OFF_R1);
  const bf16_t* ob = hg + (size_t)NTOK * 1024;
  const bf16_t* wsw = (const bf16_t*)(p.ws + OFF_W);
  const bf16_t* zg = (const bf16_t*)(p.ws + OFF_ZG);
  bf16_t* merged = (bf16_t*)(p.ws + OFF_ZR);
  const int x = blockIdx.x & 7, per = gridDim.x >> 3;
  if ((int)blockIdx.x >= per * 8) return;
  for (int q = blockIdx.x >> 3;; q += per) {
    int mt, nt;
    if (!tile_at(q, x, 1, 16, 88, 1, mt, nt)) break;
    f32x4 acc[4][6];
    zero_acc6(acc);
    gemm_loop3(acc, hg + (size_t)mt * 192 * 1024, 1024, wsw + W_RNN + (size_t)nt * 128 * 1024, 1024, 1024, smem);
    {
    const uint4* gat = (const uint4*)zg + ((size_t)(mt * 32 + nt) * 12) * 256 + opaque_u(threadIdx.x);
    uint4* ptl = (uint4*)p.out + ((size_t)(mt * 16 + nt) * 12) * 256 + opaque_u(threadIdx.x);
#pragma unroll
    for (int mm = 0; mm < 6; mm++)
#pragma unroll
      for (int n2 = 0; n2 < 2; n2++) {
        const uint4 g = gat[(mm * 2 + n2) * 256];
        uint4 o;
        o.x = pack2(acc[2 * n2][mm][0] * lo2f(g.x), acc[2 * n2][mm][1] * hi2f(g.x));
        o.y = pack2(acc[2 * n2][mm][2] * lo2f(g.y), acc[2 * n2][mm][3] * hi2f(g.y));
        o.z = pack2(acc[2 * n2 + 1][mm][0] * lo2f(g.z), acc[2 * n2 + 1][mm][1] * hi2f(g.z));
        o.w = pack2(acc[2 * n2 + 1][mm][2] * lo2f(g.w), acc[2 * n2 + 1][mm][3] * hi2f(g.w));
        ptl[(mm * 2 + n2) * 256] = o;
      }
    }
    zero_acc6(acc);
    gemm_loop3(acc, ob + (size_t)mt * 192 * 1024, 1024, wsw + W_ATT + (size_t)nt * 128 * 1024, 1024, 1024, smem);
    asm volatile("" ::: "memory");
    {
      bf16_t (*T)[136] = (bf16_t (*)[136])smem;
      __syncthreads();
      const uint4* gbt = (const uint4*)zg + ((size_t)(mt * 32 + 16 + nt) * 12) * 256 + opaque_u(threadIdx.x);
      const uint4* ptl = (const uint4*)p.out + ((size_t)(mt * 16 + nt) * 12) * 256 + opaque_u(threadIdx.x);
      bf16_t* mgt = merged + (size_t)mt * 192 * 2048 + nt * 128;
      const unsigned lrow = opaque_u(LROW3), lcol = opaque_u(LCOL2);
#pragma unroll
      for (int mm = 0; mm < 6; mm++)
#pragma unroll
        for (int n2 = 0; n2 < 2; n2++) {
          const uint4 g = gbt[(mm * 2 + n2) * 256];
          const uint4 pm = ptl[(mm * 2 + n2) * 256];
          *(uint2*)&T[lrow + mm * 16][lcol + (2 * n2) * 16] =
              make_uint2(pack2(lo2f(pm.x) + acc[2 * n2][mm][0] * lo2f(g.x), hi2f(pm.x) + acc[2 * n2][mm][1] * hi2f(g.x)),
                         pack2(lo2f(pm.y) + acc[2 * n2][mm][2] * lo2f(g.y), hi2f(pm.y) + acc[2 * n2][mm][3] * hi2f(g.y)));
          *(uint2*)&T[lrow + mm * 16][lcol + (2 * n2 + 1) * 16] =
              make_uint2(pack2(lo2f(pm.z) + acc[2 * n2 + 1][mm][0] * lo2f(g.z), hi2f(pm.z) + acc[2 * n2 + 1][mm][1] * hi2f(g.z)),
                         pack2(lo2f(pm.w) + acc[2 * n2 + 1][mm][2] * lo2f(g.w), hi2f(pm.w) + acc[2 * n2 + 1][mm][3] * hi2f(g.w)));
        }
      __syncthreads();
      const unsigned tt = opaque_u(threadIdx.x);
#pragma unroll
      for (int i = 0; i < 12; i++) {
        const unsigned c = tt + 256u * i, row = c >> 4, ch = (c & 15u) * 8u;
        *(uint4*)(mgt + (size_t)row * 2048 + ch) = *(const uint4*)&T[row][ch];
      }
    }
  }
}

__device__ void phase_wout(CParams& p, char* smem) {
  EPI_VARS
  const bf16_t* merged = (const bf16_t*)(p.ws + OFF_ZR);
  const bf16_t* wsw = (const bf16_t*)(p.ws + OFF_W);
  bf16_t* x1b = (bf16_t*)(p.ws + OFF_R1);
  const int x = blockIdx.x & 7, per = gridDim.x >> 3;
  if ((int)blockIdx.x >= per * 8) return;
  for (int q = blockIdx.x >> 3;; q += per) {
    int mt, nt;
    if (!tile_at(q, x, 1, 16, 88, 1, mt, nt)) break;
    f32x4 acc[4][6];
    zero_acc6(acc);
    gemm_loop3(acc, merged + (size_t)mt * 192 * 2048, 2048, wsw + W_OUT + (size_t)nt * 128 * 2048, 2048, 2048, smem);
    float* yt = p.out + O_Y + (size_t)mt * 192 * 2048 + nt * 128;
    bf16_t* xbt = x1b + (size_t)mt * 192 * 2048 + nt * 128;
    const unsigned lo = opaque_u(LROW3 * 2048 + LCOL2);
    const int colx = nt * 128 + LCOL2;
    bf16_t (*T)[136] = (bf16_t (*)[136])smem;
    __syncthreads();
    const unsigned lrow = opaque_u(LROW3), lcol = opaque_u(LCOL2);
#pragma unroll
    for (int mm = 0; mm < 6; mm++) {
      const float* xr = x_row(p, mt * 192 + LROW3 + mm * 16) + colx;
#pragma unroll
      for (int nn = 0; nn < 4; nn++) {
        unsigned o = lo + (unsigned)(mm * 16 * 2048 + nn * 16);
        float4 xv = *(const float4*)(xr + nn * 16);
        float4 v = make_float4(xv.x + acc[nn][mm][0], xv.y + acc[nn][mm][1], xv.z + acc[nn][mm][2], xv.w + acc[nn][mm][3]);
        *(float4*)(yt + o) = v;
        *(uint2*)&T[lrow + mm * 16][lcol + nn * 16] = make_uint2(pack2(v.x, v.y), pack2(v.z, v.w));
      }
    }
    __syncthreads();
    const unsigned tt = opaque_u(threadIdx.x);
#pragma unroll
    for (int i = 0; i < 12; i++) {
      const unsigned c = tt + 256u * i, row = c >> 4, ch = (c & 15u) * 8u;
      *(uint4*)(xbt + (size_t)row * 2048 + ch) = *(const uint4*)&T[row][ch];
    }
  }
}

__device__ void phase_pq(CParams& p, char* smem) {
  EPI_VARS
  const bf16_t* x1b = (const bf16_t*)(p.ws + OFF_R1);
  const bf16_t* wsw = (const bf16_t*)(p.ws + OFF_W);
  float* scores = (float*)(p.ws + OFF_ZG);
  bf16_t (*A2)[136] = (bf16_t (*)[136])smem;
  bf16_t (*B2)[136] = (bf16_t (*)[136])(smem + 34816);
  const int x = blockIdx.x & 7, per = gridDim.x >> 3;
  if ((int)blockIdx.x >= per * 8) return;
  for (int q = blockIdx.x >> 3;; q += per) {
    int mt, nt;
    if (!tile_at(q, x, 1, 16, 132, 1, mt, nt)) break;
    {
      f32x4 acc4[4][4];
      zero_acc4(acc4);
      gemm_loop(acc4, x1b + (size_t)mt * 128 * 2048, 2048, wsw + W_PQ + (size_t)nt * 128 * 2048, 2048, 2048, smem);
      __syncthreads();
#pragma unroll
      for (int mm = 0; mm < 4; mm++)
#pragma unroll
        for (int nn = 0; nn < 4; nn++)
          *(uint2*)&A2[LROW2 + mm * 16][LCOL2 + nn * 16] =
              make_uint2(pack2(acc4[nn][mm][0], acc4[nn][mm][1]), pack2(acc4[nn][mm][2], acc4[nn][mm][3]));
    }
    load_b2(B2, wsw + W_SK + (size_t)nt * 16384);
    __syncthreads();
    f32x16 acc[2][2];
    zero_acc(acc);
    lds_gemm128(acc, A2, B2);
    bf16_t* sct = (bf16_t*)scores + (size_t)mt * 128 * 2048 + nt * 128;
    bf16_t (*S)[136] = (bf16_t (*)[136])smem;
    __syncthreads();
    {
      const unsigned lrow = opaque_u(LROW), lcol = opaque_u(LCOL);
#pragma unroll
      for (int i = 0; i < 2; i++)
#pragma unroll
        for (int j = 0; j < 2; j++)
#pragma unroll
          for (int r = 0; r < 16; r++) S[lrow + ROWC(i, r)][lcol + j * 32] = f2bf(acc[i][j][r]);
    }
    __syncthreads();
    {
      const unsigned tt = opaque_u(threadIdx.x);
#pragma unroll
      for (int i = 0; i < 8; i++) {
        const unsigned c = tt + 256u * i, row = c >> 4, ch = (c & 15u) * 8u;
        *(uint4*)(sct + (size_t)row * 2048 + ch) = *(const uint4*)&S[row][ch];
      }
    }
  }
}

__device__ __forceinline__ unsigned f2key(float f) {
  unsigned u = __float_as_uint(f);
  return (u & 0x80000000u) ? ~u : (u | 0x80000000u);
}
#define WAVE_LDS_SYNC() asm volatile("s_waitcnt lgkmcnt(0)" ::: "memory")
template <int NV>
__device__ __forceinline__ void wave_top16(const unsigned (&key)[NV], bool (&sel)[NV], int (&pos)[NV], int lane) {
  unsigned prefix = 0;
  int bit = 31;
  bool done = false;
  {
    int c0 = 0, c1 = 0, c2 = 0, c3 = 0, c4 = 0, c5 = 0;
#pragma unroll
    for (int m = 0; m < NV; m++) {
      c0 += __popcll(__ballot(key[m] >= 0xBF000000u));
      c1 += __popcll(__ballot(key[m] >= 0xBF800000u));
      c2 += __popcll(__ballot(key[m] >= 0xC0000000u));
      c3 += __popcll(__ballot(key[m] >= 0xC0800000u));
      c4 += __popcll(__ballot(key[m] >= 0xC1000000u));
      c5 += __popcll(__ballot(key[m] >= 0xC1800000u));
    }
    if (c0 >= 16 && c5 < 16) {
      unsigned pf = 0xBF000000u; int cp = c0;
      if (c1 >= 16) { pf = 0xBF800000u; cp = c1; }
      if (c2 >= 16) { pf = 0xC0000000u; cp = c2; }
      if (c3 >= 16) { pf = 0xC0800000u; cp = c3; }
      if (c4 >= 16) { pf = 0xC1000000u; cp = c4; }
      prefix = pf;
      bit = 22;
      done = (cp == 16);
    }
  }
  for (; bit >= 0 && !done; --bit) {
    unsigned T = prefix | (1u << bit);
    int cnt = 0;
#pragma unroll
    for (int m = 0; m < NV; m++) cnt += __popcll(__ballot(key[m] >= T));
    if (cnt >= 16) prefix = T;
    if (cnt == 16) break;
  }
  const unsigned long long lt = (1ull << lane) - 1ull;
  int ngt = 0;
#pragma unroll
  for (int m = 0; m < NV; m++) ngt += __popcll(__ballot(key[m] > prefix));
  const int need = 16 - ngt;
  int eqb = 0, selb = 0;
#pragma unroll
  for (int m = 0; m < NV; m++) {
    bool gt = key[m] > prefix, eq = key[m] == prefix;
    unsigned long long em = __ballot(eq);
    int er = eqb + __popcll(em & lt);
    bool s = gt || (eq && er < need);
    unsigned long long sm = __ballot(s);
    sel[m] = s;
    pos[m] = selb + __popcll(sm & lt);
    eqb += __popcll(em);
    selb += __popcll(sm);
  }
}

__device__ void peer_token(CParams& p, int tok, char* smem) {
  const int t = threadIdx.x, lane = t & 63, w = t >> 6;
  float* s_sc = (float*)smem;
  float* s_part = s_sc + 2048;
  float* s_red = s_part + 8192;
  float* s_sel_s = s_red + 64;
  int* s_sel_i = (int*)(s_sel_s + 128);
  float* s_ew = (float*)(s_sel_i + 128);
  int* s_ei = (int*)(s_ew + 128);
  const bf16_t* scores = (const bf16_t*)(p.ws + OFF_ZG) + (size_t)tok * 2048;
  float* yrow = p.out + O_Y + (size_t)tok * 2048;
  __syncthreads();
  float4 xa = *(const float4*)(yrow + t * 8), xb = *(const float4*)(yrow + t * 8 + 4);
  float ss = xa.x * xa.x + xa.y * xa.y + xa.z * xa.z + xa.w * xa.w + xb.x * xb.x + xb.y * xb.y + xb.z * xb.z + xb.w * xb.w;
  ss = wave_sum(ss);
  if (lane == 0) s_red[w] = ss;
  {
    float sf[8];
    unpack8(*(const uint4*)(scores + t * 8), sf);
    *(float4*)(s_sc + t * 8) = make_float4(sf[0], sf[1], sf[2], sf[3]);
    *(float4*)(s_sc + t * 8 + 4) = make_float4(sf[4], sf[5], sf[6], sf[7]);
  }
  __syncthreads();
  const float rs = rsqrtf((s_red[0] + s_red[1] + s_red[2] + s_red[3]) * (1.f / 2048.f) + EPSF);
  float xn[32];
#pragma unroll
  for (int c = 0; c < 2; c++)
#pragma unroll
    for (int q4 = 0; q4 < 4; q4++) {
      float4 a = *(const float4*)(yrow + c * 1024 + lane * 16 + q4 * 4);
      xn[c * 16 + q4 * 4 + 0] = a.x * rs; xn[c * 16 + q4 * 4 + 1] = a.y * rs;
      xn[c * 16 + q4 * 4 + 2] = a.z * rs; xn[c * 16 + q4 * 4 + 3] = a.w * rs;
    }
  for (int hh = 0; hh < 2; hh++) {
    const int h = 2 * w + hh;
#pragma unroll
    for (int pp = 0; pp < 2; pp++) {
      const int base = (h * 2 + pp) * 128;
      float v[2] = {s_sc[base + lane], s_sc[base + 64 + lane]};
      unsigned key[2] = {f2key(v[0]), f2key(v[1])};
      bool sel[2]; int pos[2];
      wave_top16<2>(key, sel, pos, lane);
#pragma unroll
      for (int m = 0; m < 2; m++)
        if (sel[m]) { s_sel_s[(w * 2 + pp) * 16 + pos[m]] = v[m]; s_sel_i[(w * 2 + pp) * 16 + pos[m]] = lane + 64 * m; }
    }
    WAVE_LDS_SYNC();
    {
      float s2v = s_sel_s[(w * 2 + 1) * 16 + (lane & 15)];
      float cand[4]; unsigned key[4]; bool sel[4]; int pos[4];
#pragma unroll
      for (int m = 0; m < 4; m++) { cand[m] = s_sel_s[(w * 2) * 16 + (lane >> 4) + 4 * m] + s2v; key[m] = f2key(cand[m]); }
      wave_top16<4>(key, sel, pos, lane);
#pragma unroll
      for (int m = 0; m < 4; m++)
        if (sel[m]) {
          s_ew[h * 16 + pos[m]] = cand[m];
          s_ei[h * 16 + pos[m]] = s_sel_i[(w * 2) * 16 + (lane >> 4) + 4 * m] * 128 + s_sel_i[(w * 2 + 1) * 16 + (lane & 15)];
        }
    }
    WAVE_LDS_SYNC();
    {
      float val = s_ew[h * 16 + (lane & 15)] * rs;
      float m = val;
      m = fmaxf(m, __shfl_xor(m, 1)); m = fmaxf(m, __shfl_xor(m, 2)); m = fmaxf(m, __shfl_xor(m, 4)); m = fmaxf(m, __shfl_xor(m, 8));
      float e = __expf(val - m);
      float sum = e;
      sum += __shfl_xor(sum, 1); sum += __shfl_xor(sum, 2); sum += __shfl_xor(sum, 4); sum += __shfl_xor(sum, 8);
      if (lane < 16) s_ew[h * 16 + lane] = e / sum;
    }
    WAVE_LDS_SYNC();
  }
  float acc[32];
#pragma unroll
  for (int j = 0; j < 32; j++) acc[j] = 0.f;
#define FP8_DOT(u4, xo, hacc) {                                                        \
    const unsigned d_[4] = {u4.x, u4.y, u4.z, u4.w};                                    \
    for (int q_ = 0; q_ < 4; q_++) {                                                    \
      auto lo_ = __builtin_amdgcn_cvt_pk_f32_fp8((int)d_[q_], false);                   \
      auto hi_ = __builtin_amdgcn_cvt_pk_f32_fp8((int)d_[q_], true);                    \
      hacc += lo_[0] * xn[(xo) + q_ * 4 + 0] + lo_[1] * xn[(xo) + q_ * 4 + 1] +         \
              hi_[0] * xn[(xo) + q_ * 4 + 2] + hi_[1] * xn[(xo) + q_ * 4 + 3];          \
    } }
#define FP8_AXPY(u4, xo, wgt) {                                                        \
    const unsigned d_[4] = {u4.x, u4.y, u4.z, u4.w};                                    \
    for (int q_ = 0; q_ < 4; q_++) {                                                    \
      auto lo_ = __builtin_amdgcn_cvt_pk_f32_fp8((int)d_[q_], false);                   \
      auto hi_ = __builtin_amdgcn_cvt_pk_f32_fp8((int)d_[q_], true);                    \
      acc[(xo) + q_ * 4 + 0] += wgt * lo_[0]; acc[(xo) + q_ * 4 + 1] += wgt * lo_[1];   \
      acc[(xo) + q_ * 4 + 2] += wgt * hi_[0]; acc[(xo) + q_ * 4 + 3] += wgt * hi_[1];   \
    } }
  const unsigned char* U8 = (const unsigned char*)(p.ws + OFF_U);
  const unsigned char* V8 = (const unsigned char*)(p.ws + OFF_V);
  uint4 ru[4][2], rv[4][2];
  float g[4];
  {
#pragma unroll
    for (int u = 0; u < 4; u++) {
      const int e = s_ei[w * 32 + u];
      g[u] = s_ew[w * 32 + u];
      const uint4* up = (const uint4*)(U8 + (size_t)e * 2048) + lane;
      ru[u][0] = up[0]; ru[u][1] = up[64];
    }
#pragma unroll
    for (int u = 0; u < 4; u++) {
      const int e = s_ei[w * 32 + u];
      const uint4* vp = (const uint4*)(V8 + (size_t)e * 2048) + lane;
      rv[u][0] = vp[0]; rv[u][1] = vp[64];
    }
  }
#pragma unroll 1
  for (int q = 0; q < 32; q += 4) {
    float hh[4];
#pragma unroll
    for (int u = 0; u < 4; u++) {
      float ha = 0.f;
#pragma unroll
      for (int c = 0; c < 2; c++) FP8_DOT(ru[u][c], c * 16, ha)
      hh[u] = ha;
    }
    const int qn = (q + 4 < 32) ? q + 4 : q;
    float gn[4];
#pragma unroll
    for (int u = 0; u < 4; u++) {
      const int e = s_ei[w * 32 + qn + u];
      gn[u] = s_ew[w * 32 + qn + u];
      const uint4* up = (const uint4*)(U8 + (size_t)e * 2048) + lane;
      ru[u][0] = up[0]; ru[u][1] = up[64];
    }
#pragma unroll
    for (int o = 32; o; o >>= 1) {
#pragma unroll
      for (int u = 0; u < 4; u++) hh[u] += __shfl_xor(hh[u], o);
    }
#pragma unroll
    for (int u = 0; u < 4; u++) {
      const float wg = gelu_tanh(hh[u] * (1.f / 1024.f)) * g[u] * (1.f / 256.f);
#pragma unroll
      for (int c = 0; c < 2; c++) FP8_AXPY(rv[u][c], c * 16, wg)
    }
#pragma unroll
    for (int u = 0; u < 4; u++) {
      const int e = s_ei[w * 32 + qn + u];
      const uint4* vp = (const uint4*)(V8 + (size_t)e * 2048) + lane;
      rv[u][0] = vp[0]; rv[u][1] = vp[64];
      g[u] = gn[u];
    }
  }
#pragma unroll
  for (int c = 0; c < 2; c++) {
    float* d = s_part + w * 2048 + c * 1024 + lane * 16;
#pragma unroll
    for (int q4 = 0; q4 < 4; q4++)
      *(float4*)(d + q4 * 4) = make_float4(acc[c * 16 + q4 * 4 + 0], acc[c * 16 + q4 * 4 + 1], acc[c * 16 + q4 * 4 + 2], acc[c * 16 + q4 * 4 + 3]);
  }
  __syncthreads();
  float x2[8] = {xa.x, xa.y, xa.z, xa.w, xb.x, xb.y, xb.z, xb.w};
#pragma unroll
  for (int ww = 0; ww < 4; ww++) {
    float4 a = *(const float4*)(s_part + ww * 2048 + t * 8), b = *(const float4*)(s_part + ww * 2048 + t * 8 + 4);
    x2[0] += a.x; x2[1] += a.y; x2[2] += a.z; x2[3] += a.w; x2[4] += b.x; x2[5] += b.y; x2[6] += b.z; x2[7] += b.w;
  }
  *(float4*)(yrow + t * 8) = make_float4(x2[0], x2[1], x2[2], x2[3]);
  *(float4*)(yrow + t * 8 + 4) = make_float4(x2[4], x2[5], x2[6], x2[7]);
  float ss2 = 0.f;
#pragma unroll
  for (int j = 0; j < 8; j++) ss2 += x2[j] * x2[j];
  ss2 = wave_sum(ss2);
  if (lane == 0) s_red[8 + w] = ss2;
  __syncthreads();
  const float rs2 = rsqrtf((s_red[8] + s_red[9] + s_red[10] + s_red[11]) * (1.f / 2048.f) + EPSF);
  {
    float f[8];
#pragma unroll
    for (int j = 0; j < 8; j++) f[j] = x2[j] * rs2;
    *(uint4*)((bf16_t*)(p.ws + OFF_ZR) + (size_t)tok * 2048 + t * 8) = pack8(f);
    ((bf16_t*)(p.ws + OFF_PLB))[(size_t)tok * 256 + t] = f2bf(ple_row(p, tok)[t]);
  }
}
__device__ void phase_peer(CParams& p, char* smem) {
  for (int tok = blockIdx.x; tok < NTOK; tok += gridDim.x) peer_token(p, tok, smem);
}

__device__ void phase_ple(CParams& p, char* smem) {
  EPI_VARS
  const bf16_t* plb = (const bf16_t*)(p.ws + OFF_PLB);
  const bf16_t* x2n = (const bf16_t*)(p.ws + OFF_ZR);
  const bf16_t* wsw = (const bf16_t*)(p.ws + OFF_W);
  const int x = blockIdx.x & 7, per = gridDim.x >> 3;
  if ((int)blockIdx.x >= per * 8) return;
  for (int q = blockIdx.x >> 3;; q += per) {
    int mt, nt;
    if (!tile_at(q, x, 1, 16, 88, 1, mt, nt)) break;
    f32x4 acc[4][6];
    zero_acc6(acc);
    gemm_loop3(acc, plb + (size_t)mt * 192 * 256, 256, wsw + W_PLE + (size_t)nt * 128 * 256, 256, 256, smem);
    uint4* tmp = (uint4*)(p.ws + OFF_ZG) + ((size_t)(mt * 16 + nt) * 12) * 256 + opaque_u(threadIdx.x);
#pragma unroll
    for (int mm = 0; mm < 6; mm++)
#pragma unroll
      for (int n2 = 0; n2 < 2; n2++) {
        uint4 o;
        o.x = pack2(acc[2 * n2][mm][0], acc[2 * n2][mm][1]);
        o.y = pack2(acc[2 * n2][mm][2], acc[2 * n2][mm][3]);
        o.z = pack2(acc[2 * n2 + 1][mm][0], acc[2 * n2 + 1][mm][1]);
        o.w = pack2(acc[2 * n2 + 1][mm][2], acc[2 * n2 + 1][mm][3]);
        tmp[(mm * 2 + n2) * 256] = o;
      }
    zero_acc6(acc);
    gemm_loop3(acc, x2n + (size_t)mt * 192 * 2048, 2048, wsw + W_GATE + (size_t)nt * 128 * 2048, 2048, 2048, smem);
    asm volatile("" ::: "memory");
    float* yt = p.out + O_Y + (size_t)mt * 192 * 2048 + nt * 128;
    const unsigned lo = opaque_u(LROW3 * 2048 + LCOL2);
#pragma unroll
    for (int mm = 0; mm < 6; mm++)
#pragma unroll
      for (int n2 = 0; n2 < 2; n2++) {
        const uint4 a1 = tmp[(mm * 2 + n2) * 256];
#pragma unroll
        for (int h2 = 0; h2 < 2; h2++) {
          const int nn = 2 * n2 + h2;
          const unsigned alo = h2 ? a1.z : a1.x, ahi = h2 ? a1.w : a1.y;
          float4* yp = (float4*)(yt + lo + (unsigned)(mm * 16 * 2048 + nn * 16));
          float4 y = *yp;
          y.x += lo2f(alo) * sigmoidf_(acc[nn][mm][0]);
          y.y += hi2f(alo) * sigmoidf_(acc[nn][mm][1]);
          y.z += lo2f(ahi) * sigmoidf_(acc[nn][mm][2]);
          y.w += hi2f(ahi) * sigmoidf_(acc[nn][mm][3]);
          *yp = y;
        }
      }
  }
}

#define XB_TMO      128
#define XB_XCNT(j)  (256  + 64 * (j))
#define XB_XSUB(j)  (1280 + 64 * (j))
#define XB_XGEN(j)  (2304 + 64 * (j))
#define XB_TOP      3328
#define XB_TOPGEN   3392
#define XB_SPIN_CAP (1u << 22)
__device__ __forceinline__ unsigned xb_ld(unsigned* p) { return __hip_atomic_load(p, __ATOMIC_RELAXED, __HIP_MEMORY_SCOPE_AGENT); }
__device__ __forceinline__ unsigned xb_add(unsigned* p, unsigned v) { return __hip_atomic_fetch_add(p, v, __ATOMIC_RELAXED, __HIP_MEMORY_SCOPE_AGENT); }
__device__ __forceinline__ unsigned xb_xcc_id() { return (unsigned)__builtin_amdgcn_s_getreg((3 << 11) | 20) & 0xFu; }
#define XB_SPIN(cond, bar) do { unsigned _sp = 0; while (cond) { __builtin_amdgcn_s_sleep(1); \
    if ((++_sp & 255u) == 0u) { if (xb_ld(&(bar)[XB_TMO])) break; if (_sp > XB_SPIN_CAP) { atomicAdd(&(bar)[XB_TMO], 1u); break; } } } } while (0)

__device__ __forceinline__ void xcd_barrier_post(unsigned* bar) {
  if (threadIdx.x == 0) (void)xb_add(&bar[XB_XCNT(xb_xcc_id())], 1u);
}
__device__ __noinline__ void xcd_sync(unsigned* bar) {
  asm volatile("s_waitcnt vmcnt(0)" ::: "memory");
  __syncthreads();
  if (threadIdx.x == 0) {
    __builtin_amdgcn_s_waitcnt(0);
    const unsigned x = xb_xcc_id();
    unsigned packed = bar[3456 + blockIdx.x];
    unsigned nloc = packed & 0xffffu, nx = packed >> 16;
    if (nloc == 0u) {
      const unsigned G = gridDim.x;
      unsigned sum, cnt, mine, sp = 0u;
      for (;;) {
        sum = 0u; cnt = 0u; mine = 0u;
#pragma unroll
        for (unsigned j = 0; j < 16; ++j) { const unsigned c = xb_ld(&bar[XB_XCNT(j)]); sum += c; cnt += (c > 0u) ? 1u : 0u; mine = (j == x) ? c : mine; }
        if (sum == G) break;
        __builtin_amdgcn_s_sleep(1);
        if ((++sp & 255u) == 0u) { if (xb_ld(&bar[XB_TMO])) break; if (sp > XB_SPIN_CAP) { atomicAdd(&bar[XB_TMO], 1u); break; } }
      }
      nloc = mine > 0u ? mine : 1u; nx = cnt > 0u ? cnt : 1u;
      bar[3456 + blockIdx.x] = nloc | (nx << 16);
    }
    const unsigned old = xb_add(&bar[XB_XSUB(x)], 1u);
    const unsigned gen = old / nloc;
    if (old + 1u == (gen + 1u) * nloc) {
      __builtin_amdgcn_fence(__ATOMIC_RELEASE, "agent");
      asm volatile("s_waitcnt vmcnt(0)" ::: "memory");
      const unsigned og = xb_add(&bar[XB_TOP], 1u);
      const unsigned tg = og / nx;
      if (og + 1u == (tg + 1u) * nx) xb_add(&bar[XB_TOPGEN], 1u);
      else XB_SPIN(xb_ld(&bar[XB_TOPGEN]) == tg, bar);
      __builtin_amdgcn_fence(__ATOMIC_ACQUIRE, "agent");
      xb_add(&bar[XB_XGEN(x)], 1u);
      asm volatile("s_waitcnt vmcnt(0)" ::: "memory");
    } else {
      XB_SPIN(xb_ld(&bar[XB_XGEN(x)]) == gen, bar);
      __builtin_amdgcn_fence(__ATOMIC_ACQUIRE, "agent");
      asm volatile("s_waitcnt vmcnt(0)" ::: "memory");
    }
  }
  __syncthreads();
}

__global__ void __launch_bounds__(256, 2) mega_kernel(Params p_unused) {
  __shared__ __attribute__((aligned(16))) char smem[81920];
  xcd_barrier_post((unsigned*)(get_params()->ws + OFF_BAR));
  { CParams& p = *get_params(); phase_prep(p, smem); }
  xcd_sync((unsigned*)(get_params()->ws + OFF_BAR));
  { CParams& p = *get_params(); phase_gemm1(p, smem); }
  xcd_sync((unsigned*)(get_params()->ws + OFF_BAR));
  { CParams& p = *get_params(); phase_mix(p, smem); }
  xcd_sync((unsigned*)(get_params()->ws + OFF_BAR));
  { CParams& p = *get_params(); phase_scan2(p); }
  xcd_sync((unsigned*)(get_params()->ws + OFF_BAR));
  { CParams& p = *get_params(); phase_proj(p, smem); }
  xcd_sync((unsigned*)(get_params()->ws + OFF_BAR));
  { CParams& p = *get_params(); phase_wout(p, smem); }
  xcd_sync((unsigned*)(get_params()->ws + OFF_BAR));
  { CParams& p = *get_params(); phase_pq(p, smem); }
  xcd_sync((unsigned*)(get_params()->ws + OFF_BAR));
  { CParams& p = *get_params(); phase_peer(p, smem); }
  xcd_sync((unsigned*)(get_params()->ws + OFF_BAR));
  { CParams& p = *get_params(); phase_ple(p, smem); }
  if (get_params()->ws == nullptr) cg::this_grid().sync();
}

extern "C" void kernel_launch(void* const* d_in, const int* in_sizes, int n_in, void* d_out, int out_size, void* d_ws,
                              size_t ws_size, hipStream_t stream) {
  static int grid_blocks = 0;
  if (!grid_blocks) {
    int dev = 0, cus = 0, per_cu = 0;
    hipGetDevice(&dev);
    hipDeviceGetAttribute(&cus, hipDeviceAttributeMultiprocessorCount, dev);
    hipOccupancyMaxActiveBlocksPerMultiprocessor(&per_cu, mega_kernel, 256, 0);
    if (per_cu > 2) per_cu = 2;
    grid_blocks = cus * per_cu;
    if (ws_size < WS_NEED) fprintf(stderr, "workspace too small: %zu < %zu\n", ws_size, (size_t)WS_NEED);
  }
  Params p{};
  const float** pp = (const float**)&p;
  for (int i = 0; i < 31; i++) pp[i] = (const float*)d_in[i];
  p.out = (float*)d_out;
  p.ws = (char*)d_ws;
  hipMemsetAsync((char*)d_ws + OFF_BAR, 0, 16384, stream);
  void* args[] = {&p};
  hipError_t e = hipLaunchCooperativeKernel((void*)mega_kernel, dim3(grid_blocks), dim3(256), args, 0, stream);
  if (e != hipSuccess) fprintf(stderr, "cooperative launch failed: %s (grid %d)\n", hipGetErrorString(e), grid_blocks);
}
```
